# Optimizing an MI355X kernel written in HIP

```python
import jax, jax.numpy as jnp
from jax import lax
import numpy as np

D_MODEL = 1024
BATCH = 8
SEQ = 2048
DEPTH = 4
DEC_BATCH = 8
DEC_SEQ = 64
PAST_LEN = 1024

CHUNK = 64
D_MIX = D_MODEL
D_POOL = D_MIX // 2
D_CONV = D_MIX - D_POOL
POOL_WINDOWS = (2, 4, 8, 16)
N_POOL_GROUPS = len(POOL_WINDOWS)
POOL_GROUP = D_POOL // N_POOL_GROUPS
POOL_STATE = max(POOL_WINDOWS) - 1
N_CONV_HEADS = 8
CONV_HEAD = D_CONV // N_CONV_HEADS
CONV_WIDTH = 3
D_FF = ((8 * D_MODEL // 3 + 127) // 128) * 128
D_IN = D_POOL + 3 * D_CONV
EPS = 1e-6

kernel_name = "hybrid_pool_shortconv_streaming_encoder_step"


def rmsnorm(x, g):
    xf = x.astype(jnp.float32)
    y = xf * lax.rsqrt(jnp.mean(xf * xf, axis=-1, keepdims=True) + EPS)
    return (y * g.astype(jnp.float32)).astype(x.dtype)


def head_rmsnorm(x, n_heads, g):
    b, t, c = x.shape
    xf = x.astype(jnp.float32).reshape(b, t, n_heads, c // n_heads)
    y = xf * lax.rsqrt(jnp.mean(xf * xf, axis=-1, keepdims=True) + EPS)
    return (y.reshape(b, t, c) * g.astype(jnp.float32)).astype(x.dtype)


def causal_dwconv(x, buf, w):
    t = x.shape[1]
    xp = jnp.concatenate([buf.astype(x.dtype), x], axis=1)
    y = sum(w[k] * xp[:, k:k + t] for k in range(CONV_WIDTH))
    return y, xp[:, -(CONV_WIDTH - 1):]


def multiscale_pool(v, buf, offset):
    b, t, c = v.shape
    L = POOL_STATE
    xp = jnp.concatenate([buf.astype(v.dtype), v], axis=1)
    cs = jnp.cumsum(xp.astype(jnp.float32), axis=1)
    cs0 = jnp.concatenate([jnp.zeros((b, 1, c), jnp.float32), cs], axis=1)
    pos = offset + jnp.arange(t)
    means = []
    for gi, w in enumerate(POOL_WINDOWS):
        sl = slice(gi * POOL_GROUP, (gi + 1) * POOL_GROUP)
        s = cs0[:, L + 1:L + 1 + t, sl] - cs0[:, L + 1 - w:L + 1 - w + t, sl]
        cnt = jnp.minimum(pos + 1, w).astype(jnp.float32)[None, :, None]
        means.append(s / cnt)
    mean = jnp.concatenate(means, axis=-1)
    out = (mean - v.astype(jnp.float32)).astype(v.dtype)
    return out, xp[:, -L:]


def layer(x, pool_buf, conv_buf, ffn_buf, offset, w_in, pool_mix, pool_scale, conv_w,
          g_pool_out, g_conv_out, w_out, g_pre_mix, g_post_mix, g_pre_ffn, g_post_ffn,
          w_up, ffn_conv_w, w_down):
    b, t, _ = x.shape
    h = rmsnorm(x, g_pre_mix)
    z = h @ w_in
    v = z[..., :D_POOL]
    gb = z[..., D_POOL:D_POOL + D_CONV]
    gc = z[..., D_POOL + D_CONV:D_POOL + 2 * D_CONV]
    u = z[..., D_POOL + 2 * D_CONV:]
    pooled, new_pool = multiscale_pool(v, pool_buf, offset)
    ya = jnp.einsum('btgc,gcd->btgd', pooled.reshape(b, t, N_POOL_GROUPS, POOL_GROUP),
                    pool_mix).reshape(b, t, D_POOL) * pool_scale
    conv_out, new_conv = causal_dwconv(gc * u, conv_buf, conv_w)
    yb = gb * conv_out
    mix = jnp.concatenate([head_rmsnorm(ya, N_POOL_GROUPS, g_pool_out),
                           head_rmsnorm(yb, N_CONV_HEADS, g_conv_out)], axis=-1) @ w_out
    x = x + rmsnorm(mix, g_post_mix)
    h = rmsnorm(x, g_pre_ffn)
    up, new_ffn = causal_dwconv(h @ w_up, ffn_buf, ffn_conv_w)
    f = (jax.nn.silu(up[..., :D_FF]) * up[..., D_FF:]) @ w_down
    x = x + rmsnorm(f, g_post_ffn)
    return x, new_pool, new_conv, new_ffn


def setup_inputs(seed: int = 0) -> dict:
    key = jax.random.key(seed)
    ks = jax.random.split(key, 24)
    f32 = jnp.float32

    def nrm(k, shape, scale):
        return jax.random.normal(k, shape, f32) * scale

    def gain(k, shape):
        return 1.0 + 0.02 * jax.random.normal(k, shape, f32)

    return {
        "x_prompt": nrm(ks[0], (BATCH, SEQ, D_MODEL), 1.0),
        "x_sample": nrm(ks[1], (DEC_BATCH, DEC_SEQ, D_MODEL), 1.0),
        "state_pool": nrm(ks[2], (DEPTH, DEC_BATCH, POOL_STATE, D_POOL), 1.0),
        "state_conv": nrm(ks[3], (DEPTH, DEC_BATCH, CONV_WIDTH - 1, D_CONV), 1.0),
        "state_ffn_conv": nrm(ks[4], (DEPTH, DEC_BATCH, CONV_WIDTH - 1, 2 * D_FF), 1.0),
        "w_in": nrm(ks[5], (DEPTH, D_MODEL, D_IN), D_MODEL ** -0.5),
        "pool_mix": nrm(ks[6], (DEPTH, N_POOL_GROUPS, POOL_GROUP, POOL_GROUP), POOL_GROUP ** -0.5),
        "pool_scale": gain(ks[7], (DEPTH, D_POOL)),
        "conv_w": nrm(ks[8], (DEPTH, CONV_WIDTH, D_CONV), CONV_WIDTH ** -0.5),
        "g_pool_out": gain(ks[9], (DEPTH, D_POOL)),
        "g_conv_out": gain(ks[10], (DEPTH, D_CONV)),
        "w_out": nrm(ks[11], (DEPTH, D_MIX, D_MODEL), D_MIX ** -0.5),
        "g_pre_mix": gain(ks[12], (DEPTH, D_MODEL)),
        "g_post_mix": gain(ks[13], (DEPTH, D_MODEL)),
        "g_pre_ffn": gain(ks[14], (DEPTH, D_MODEL)),
        "g_post_ffn": gain(ks[15], (DEPTH, D_MODEL)),
        "w_up": nrm(ks[16], (DEPTH, D_MODEL, 2 * D_FF), D_MODEL ** -0.5),
        "ffn_conv_w": nrm(ks[17], (DEPTH, CONV_WIDTH, 2 * D_FF), CONV_WIDTH ** -0.5),
        "w_down": nrm(ks[18], (DEPTH, D_FF, D_MODEL), D_FF ** -0.5),
        "g_final": gain(ks[19], (D_MODEL,)),
    }


def reference(x_prompt, x_sample, state_pool, state_conv, state_ffn_conv, w_in, pool_mix,
              pool_scale, conv_w, g_pool_out, g_conv_out, w_out, g_pre_mix, g_post_mix,
              g_pre_ffn, g_post_ffn, w_up, ffn_conv_w, w_down, g_final):
    bp = x_prompt.shape[0]
    dt = x_prompt.dtype
    xp, xs = x_prompt, x_sample
    pool_p, conv_p, ffn_p, pool_s, conv_s, ffn_s = [], [], [], [], [], []
    for l in range(DEPTH):
        weights = (w_in[l], pool_mix[l], pool_scale[l], conv_w[l], g_pool_out[l], g_conv_out[l],
                   w_out[l], g_pre_mix[l], g_post_mix[l], g_pre_ffn[l], g_post_ffn[l],
                   w_up[l], ffn_conv_w[l], w_down[l])
        xp, a, c, f = layer(xp,
                            jnp.zeros((bp, POOL_STATE, D_POOL), dt),
                            jnp.zeros((bp, CONV_WIDTH - 1, D_CONV), dt),
                            jnp.zeros((bp, CONV_WIDTH - 1, 2 * D_FF), dt),
                            0, *weights)
        pool_p.append(a); conv_p.append(c); ffn_p.append(f)
        xs, a, c, f = layer(xs, state_pool[l], state_conv[l], state_ffn_conv[l],
                            PAST_LEN, *weights)
        pool_s.append(a); conv_s.append(c); ffn_s.append(f)
    y_prompt = rmsnorm(xp, g_final)
    y_sample = rmsnorm(xs, g_final)
    return (y_prompt, y_sample,
            jnp.stack(pool_p), jnp.stack(conv_p), jnp.stack(ffn_p),
            jnp.stack(pool_s), jnp.stack(conv_s), jnp.stack(ffn_s))
```

```cpp
#include <hip/hip_runtime.h>
#include <hip/hip_cooperative_groups.h>
#include <cstdio>
#include <cstdint>
namespace cg = cooperative_groups;

namespace pg8 {
#define PG8_LAS __attribute__((address_space(3)))
typedef unsigned short bf16_t;
typedef short bf16x8 __attribute__((ext_vector_type(8)));
typedef float f32x4 __attribute__((ext_vector_type(4)));
typedef unsigned u32x4 __attribute__((ext_vector_type(4)));
constexpr int BM = 256, BK = 64, HALF = 128, HTB = HALF * BK * 2  , STAGE_BYTES = 8 * HTB, NXCD = 8, WGM = 8;

__host__ __device__ __forceinline__ int lds_byte(int r, int c) { const int st = (r >> 4) * 2 + (c >> 5), rr = r & 15, cc = c & 31, ob = rr * 64 + cc * 2; return st * 1024 + (ob ^ (((ob >> 9) & 1) << 5)); }
__host__ __device__ __forceinline__ void stage_rc(int b, int& R, int& C) { const int st = b / 1024, sb = b % 1024, swz = sb ^ (((sb >> 9) & 1) << 5); R = (st >> 1) * 16 + swz / 64; C = (st & 1) * 32 + (swz % 64) / 2; }
__host__ __device__ __forceinline__ int perm32(int rho) { const int n = rho >> 4, i = rho & 15; return 8 * (i >> 2) + 4 * n + (i & 3); }

__device__ __forceinline__ int lane_id_asm() { int l; asm volatile("v_mbcnt_lo_u32_b32 %0, -1, 0\n\tv_mbcnt_hi_u32_b32 %0, -1, %0" : "=v"(l)); return l; }
struct Unit { int pm, pn, ks, k0, nt; };
struct Gemm { const bf16_t* A; const bf16_t* Bt; int ld; };

struct MixedOrder {
    int nN, nP, nS, ntF, ntS, nwg, G, c;
    __host__ __device__ __forceinline__ void init(int N, int ntFull, int nSplit, int G_, int c_) { nN = N / BM; nP = 64 * nN; nS = nSplit; ntF = ntFull; ntS = nSplit ? ntFull / nSplit : 0; nwg = nP + 2 * nN * nS;   G = G_; c = c_; }
    __host__ __device__ __forceinline__ bool next(int i, Unit& u) const {
        const long L = (long)i * G + c; if (L >= nwg) return false;
        int wgid = (int)L;
        if (wgid < nP) {
            { const int q = nP / NXCD, xcd = wgid % NXCD, off = wgid / NXCD; wgid = xcd * q + off; }
            const int nig = WGM * nN, gid = wgid / nig, fm = gid * WGM;
            u.pm = fm + ((wgid % nig) % WGM); u.pn = (wgid % nig) / WGM; u.ks = 0; u.k0 = 0; u.nt = ntF;
        } else {
            wgid -= nP; u.ks = wgid % nS; const int t = wgid / nS; u.pm = 64 + t / nN; u.pn = t % nN; u.k0 = u.ks * ntS; u.nt = ntS;
        }
        return true;
    }
    __device__ __forceinline__ void a_ready(const Unit&) const {}
    __device__ __forceinline__ void done(const Unit&) const {}
};

struct SampleOrder {
    int nN, ntF, c;
    __host__ __device__ __forceinline__ void init(int N, int ntFull, int c_) { nN = N / BM; ntF = ntFull; c = c_; }
    __host__ __device__ __forceinline__ bool next(int i, Unit& u) const { if (i != 0 || c >= 2 * nN) return false; u.pm = 64 + c / nN; u.pn = c % nN; u.ks = 0; u.k0 = 0; u.nt = ntF; return true; }
    __device__ __forceinline__ void a_ready(const Unit&) const {}
    __device__ __forceinline__ void done(const Unit&) const {}
};
__device__ __forceinline__ unsigned cvt_pk_bf16(float lo, float hi) { unsigned r; asm volatile("v_cvt_pk_bf16_f32 %0, %1, %2" : "=v"(r) : "v"(lo), "v"(hi)); return r; }

struct EpiStore {
    static constexpr bool PERM = true, AFTER_DRAIN = false;
    bf16_t* O; int ldc; float* PART; const float* rs;
    __device__ __forceinline__ void operator()(const f32x4 (&acc)[2][2][4][2], const Unit& u, int wr, int wc, int fr, int fq) const {
        const int row0 = u.pm * BM + wr * 64 + fr, col0 = u.pn * BM + wc * 32 + 8 * fq;
        if (PART != nullptr && u.pm >= 64) {
            float* base = PART + (size_t)u.ks * 512 * ldc;
#pragma unroll
            for (int ai = 0; ai < 2; ++ai)
#pragma unroll
                for (int m = 0; m < 4; ++m) { float* rowp = base + (size_t)(row0 - 16384 + ai * HALF + m * 16) * ldc + col0;
#pragma unroll
                    for (int bj = 0; bj < 2; ++bj) { *(f32x4*)(rowp + bj * HALF) = acc[ai][bj][m][0]; *(f32x4*)(rowp + bj * HALF + 4) = acc[ai][bj][m][1]; } }
            return;
        }
#pragma unroll
        for (int ai = 0; ai < 2; ++ai)
#pragma unroll
            for (int m = 0; m < 4; ++m) { bf16_t* rowp = O + (size_t)(row0 + ai * HALF + m * 16) * ldc + col0; const float r = rs ? rs[row0 + ai * HALF + m * 16] : 1.0f;
#pragma unroll
                for (int bj = 0; bj < 2; ++bj) { const f32x4 v0 = acc[ai][bj][m][0] * r, v1 = acc[ai][bj][m][1] * r;
                    u32x4 w; w.x = cvt_pk_bf16(v0[0], v0[1]); w.y = cvt_pk_bf16(v0[2], v0[3]); w.z = cvt_pk_bf16(v1[0], v1[1]); w.w = cvt_pk_bf16(v1[2], v1[3]);
                    *(u32x4*)(rowp + bj * HALF) = w; } }
    }
};

__device__ __forceinline__ float silu_f(float x) { return x * __builtin_amdgcn_rcpf(1.0f + __expf(-x)); }

struct EpiUp {
    static constexpr bool PERM = true, AFTER_DRAIN = false;
    bf16_t* ACT; float* HEAD; float* TAIL; const float* cw; const float* rs;
    typedef float f32x2 __attribute__((ext_vector_type(2)));
    __device__ __forceinline__ void operator()(f32x4 (&acc)[2][2][4][2], const Unit& u, int wr, int wc, int fr, int fq) const {
        const int lane = fr + 16 * fq;
        { float rr[2][4];
#pragma unroll
          for (int ai = 0; ai < 2; ++ai)
#pragma unroll
              for (int m = 0; m < 4; ++m) rr[ai][m] = rs[u.pm * BM + ai * HALF + wr * 64 + m * 16 + fr];
#pragma unroll
          for (int ai = 0; ai < 2; ++ai)
#pragma unroll
              for (int m = 0; m < 4; ++m)
#pragma unroll
                  for (int bj = 0; bj < 2; ++bj) { acc[ai][bj][m][0] *= rr[ai][m]; acc[ai][bj][m][1] *= rr[ai][m]; } }
        const int src1 = (lane & 48) | ((fr + 15) & 15), src2 = (lane & 48) | ((fr + 14) & 15);
        const int chl = wc * 32 + 8 * fq, ch0 = u.pn * 128 + chl;
        f32x2 wgk[3], wvk[3], wgn[3], wvn[3];
#pragma unroll
        for (int k = 0; k < 3; ++k) { wgk[k] = *(const f32x2*)(cw + k * 5632 + ch0); wvk[k] = *(const f32x2*)(cw + k * 5632 + 2816 + ch0); }
        unsigned pw[2][4][4];
#pragma unroll
        for (int gi = 0; gi < 4; ++gi) {
            const int n = gi >> 1, jp = gi & 1;
            if (gi < 3) {
#pragma unroll
                for (int k = 0; k < 3; ++k) { wgn[k] = *(const f32x2*)(cw + k * 5632 + ch0 + 2 * (gi + 1)); wvn[k] = *(const f32x2*)(cw + k * 5632 + 2816 + ch0 + 2 * (gi + 1)); }
            }
#pragma unroll
            for (int ai = 0; ai < 2; ++ai) {
                float av[4][2];
#pragma unroll
                for (int jj = 0; jj < 2; ++jj) {
                    const int j = 2 * jp + jj;
                    float s1g[4], s2g[4], s1v[4], s2v[4];
#pragma unroll
                    for (int m = 0; m < 4; ++m) {
                        s1g[m] = __shfl(acc[ai][0][m][n][j], src1); s2g[m] = __shfl(acc[ai][0][m][n][j], src2);
                        s1v[m] = __shfl(acc[ai][1][m][n][j], src1); s2v[m] = __shfl(acc[ai][1][m][n][j], src2);
                    }
#pragma unroll
                    for (int m = 0; m < 4; ++m) {
                        const int mp = m > 0 ? m - 1 : 0;
                        const float g0 = acc[ai][0][m][n][j], g1 = fr >= 1 ? s1g[m] : s1g[mp], g2 = fr >= 2 ? s2g[m] : s2g[mp];
                        const float v0 = acc[ai][1][m][n][j], v1 = fr >= 1 ? s1v[m] : s1v[mp], v2 = fr >= 2 ? s2v[m] : s2v[mp];
                        const float cgv = wgk[0][jj] * g2 + wgk[1][jj] * g1 + wgk[2][jj] * g0;
                        const float cvv = wvk[0][jj] * v2 + wvk[1][jj] * v1 + wvk[2][jj] * v0;
                        av[m][jj] = silu_f(cgv) * cvv;
                    }
                }
#pragma unroll
                for (int m = 0; m < 4; ++m) pw[ai][m][gi] = cvt_pk_bf16(av[m][0], av[m][1]);
                __builtin_amdgcn_sched_barrier(0);
            }
            if (gi < 3) {
#pragma unroll
                for (int k = 0; k < 3; ++k) { wgk[k] = wgn[k]; wvk[k] = wvn[k]; }
            }
        }
#pragma unroll
        for (int ai = 0; ai < 2; ++ai) {
            const int blk = 4 * u.pm + 2 * ai + wr;
            if (fr < 2) {
#pragma unroll
                for (int bj = 0; bj < 2; ++bj)
#pragma unroll
                    for (int n = 0; n < 2; ++n) *(f32x4*)(HEAD + ((size_t)blk * 2 + fr) * 5632 + u.pn * 256 + bj * 128 + chl + 4 * n) = acc[ai][bj][0][n];
            }
            if (fr >= 14) {
#pragma unroll
                for (int bj = 0; bj < 2; ++bj)
#pragma unroll
                    for (int n = 0; n < 2; ++n) *(f32x4*)(TAIL + ((size_t)blk * 2 + (fr - 14)) * 5632 + u.pn * 256 + bj * 128 + chl + 4 * n) = acc[ai][bj][3][n];
            }
#pragma unroll
            for (int m = 0; m < 4; ++m) {
                if (m > 0 || fr >= 2) {
                    u32x4 w; w.x = pw[ai][m][0]; w.y = pw[ai][m][1]; w.z = pw[ai][m][2]; w.w = pw[ai][m][3];
                    *(u32x4*)(ACT + (size_t)(64 * blk + 16 * m + fr) * 2816 + ch0) = w;
                }
            }
        }
    }
};

template <class Epi, class Sched, bool ALIGN_EPI = false, bool SP2 = false>
__device__ __forceinline__ void gemm_phase(PG8_LAS unsigned char* lds, const Gemm g, const Sched& S, const Epi& E, const int wave_s) {
    const int wid = wave_s, lane = lane_id_asm(), tid = wid * 64 + lane, wr = wid >> 2, wc = wid & 3, fr = lane & 15, fq = lane >> 4;
    const int K = g.ld;
    unsigned voffA[2], voffB[2];
#pragma unroll
    for (int i = 0; i < 2; ++i) { int R, C; stage_rc(tid * 16 + i * 8192, R, C); const int Rb = Epi::PERM ? ((R & ~31) + perm32(R & 31)) : R;
        voffA[i] = (unsigned)(R * K + C) * 2u; voffB[i] = (unsigned)(Rb * K + C) * 2u; }
    const size_t kstep = (size_t)(BK * 2);
    const size_t hstep = (size_t)HALF * K * 2;
    const size_t tstep = 2 * hstep;
    const unsigned ldsw = (unsigned)wid * 1024u;
    const int aoff = lds_byte(wr * 64 + fr, fq * 8), boff = lds_byte(wc * 32 + fr, fq * 8);
#define PG8_SA(b, h) (((b) * 2 + (h)) * HTB)
#define PG8_SB(b, h) ((4 + (b) * 2 + (h)) * HTB)
#define PG8_STAGE(bufoff, gbase, voff) do { _Pragma("unroll") for (int _i = 0; _i < 2; ++_i) \
        __builtin_amdgcn_global_load_lds((const unsigned*)((const char*)(gbase) + (voff)[_i]), (PG8_LAS unsigned*)(lds + (bufoff) + ldsw + _i * 8192), 16, 0, 0); } while (0)
#define PG8_LDA(dst, b, h) do { _Pragma("unroll") for (int m = 0; m < 4; ++m) _Pragma("unroll") for (int k = 0; k < 2; ++k) dst[m][k] = *(const PG8_LAS bf16x8*)(lds + PG8_SA(b, h) + aoff + m * 2048 + k * 1024); } while (0)
#define PG8_LDB(dst, b, h) do { _Pragma("unroll") for (int n = 0; n < 2; ++n) _Pragma("unroll") for (int k = 0; k < 2; ++k) dst[n][k] = *(const PG8_LAS bf16x8*)(lds + PG8_SB(b, h) + boff + n * 2048 + k * 1024); } while (0)
#define PG8_MMA(ai, bj, At, Bt) do { __builtin_amdgcn_s_setprio(1); _Pragma("unroll") for (int m = 0; m < 4; ++m) _Pragma("unroll") for (int n = 0; n < 2; ++n) _Pragma("unroll") for (int k = 0; k < 2; ++k) \
        acc[ai][bj][m][n] = __builtin_amdgcn_mfma_f32_16x16x32_bf16(Bt[n][k], At[m][k], acc[ai][bj][m][n], 0, 0, 0); __builtin_amdgcn_s_setprio(0); } while (0)
#define PG8_WAIT_V(n) asm volatile("s_waitcnt vmcnt(" #n ")" ::: "memory")
#define PG8_WAIT_L(n) asm volatile("s_waitcnt lgkmcnt(" #n ")" ::: "memory")
#define PG8_BAR __builtin_amdgcn_s_barrier()
#define PG8_SCHED __builtin_amdgcn_sched_barrier(0)
    Unit cur, nxt; int ui = 0;
    if (!S.next(0, cur)) return;
    f32x4 acc[2][2][4][2];
#pragma unroll
    for (int a = 0; a < 2; ++a)
#pragma unroll
        for (int b = 0; b < 2; ++b)
#pragma unroll
            for (int m = 0; m < 4; ++m)
#pragma unroll
                for (int n = 0; n < 2; ++n) acc[a][b][m][n] = (f32x4){0.f, 0.f, 0.f, 0.f};
    bf16x8 At[4][2], B0[2][2], B1[2][2];
    const char* cA = (const char*)g.A + (size_t)cur.pm * tstep + (size_t)cur.k0 * kstep; const char* cB = (const char*)g.Bt + (size_t)cur.pn * tstep + (size_t)cur.k0 * kstep;
    S.a_ready(cur);
    if constexpr (SP2) {
        PG8_STAGE(PG8_SB(0, 0), cB, voffB); PG8_STAGE(PG8_SB(0, 1), cB + hstep, voffB); PG8_STAGE(PG8_SA(0, 0), cA, voffA); PG8_STAGE(PG8_SA(0, 1), cA + hstep, voffA);
        if (wr == 1) PG8_BAR;
        PG8_WAIT_V(2); PG8_BAR;
        PG8_STAGE(PG8_SB(1, 0), cB + kstep, voffB); PG8_STAGE(PG8_SA(1, 0), cA + kstep, voffA); PG8_STAGE(PG8_SB(1, 1), cB + hstep + kstep, voffB);
        PG8_WAIT_V(6); PG8_BAR;
    } else {
        PG8_STAGE(PG8_SB(0, 0), cB, voffB); PG8_STAGE(PG8_SA(0, 0), cA, voffA); PG8_STAGE(PG8_SB(0, 1), cB + hstep, voffB); PG8_STAGE(PG8_SA(0, 1), cA + hstep, voffA);
        if (wr == 1) PG8_BAR;
        PG8_WAIT_V(4); PG8_BAR;
        PG8_STAGE(PG8_SB(1, 0), cB + kstep, voffB); PG8_STAGE(PG8_SA(1, 0), cA + kstep, voffA); PG8_STAGE(PG8_SB(1, 1), cB + hstep + kstep, voffB);
        PG8_WAIT_V(6); PG8_BAR;
    }
    for (;;) {
        const bool has_next = S.next(ui + 1, nxt); const int nt = cur.nt;
        const char* nA = has_next ? (const char*)g.A + (size_t)nxt.pm * tstep + (size_t)nxt.k0 * kstep : cA; const char* nB = has_next ? (const char*)g.Bt + (size_t)nxt.pn * tstep + (size_t)nxt.k0 * kstep : cB;
        for (int t = 0; t < nt; t += 2) {
            const bool last = (t == nt - 2);
            const char* a1 = cA + (size_t)(t + 1) * kstep;
            const char* a2 = last ? nA : cA + (size_t)(t + 2) * kstep; const char* b2 = last ? nB : cB + (size_t)(t + 2) * kstep;
            const char* a3 = a2 + kstep; const char* b3 = b2 + kstep;
            if (last && has_next) S.a_ready(nxt);
            if constexpr (SP2) {
            PG8_LDB(B0, 0, 0); PG8_LDB(B1, 0, 1); PG8_SCHED; PG8_LDA(At, 0, 0); PG8_STAGE(PG8_SA(1, 1), a1 + hstep, voffA);
            PG8_WAIT_V(8); PG8_WAIT_L(0); PG8_BAR; PG8_MMA(0, 0, At, B0); PG8_MMA(0, 1, At, B1); PG8_BAR; PG8_SCHED;
            PG8_LDA(At, 0, 1); PG8_STAGE(PG8_SB(0, 0), b2, voffB); PG8_STAGE(PG8_SB(0, 1), b2 + hstep, voffB); PG8_STAGE(PG8_SA(0, 0), a2, voffA);
            PG8_WAIT_V(8); PG8_WAIT_L(0); PG8_BAR; PG8_MMA(1, 0, At, B0); PG8_MMA(1, 1, At, B1); PG8_BAR; PG8_SCHED;
            PG8_LDB(B0, 1, 0); PG8_LDB(B1, 1, 1); PG8_SCHED; PG8_LDA(At, 1, 0); PG8_STAGE(PG8_SA(0, 1), a2 + hstep, voffA);
            PG8_WAIT_V(8); PG8_WAIT_L(0); PG8_BAR; PG8_MMA(0, 0, At, B0); PG8_MMA(0, 1, At, B1); PG8_BAR; PG8_SCHED;
            PG8_LDA(At, 1, 1); PG8_STAGE(PG8_SB(1, 0), b3, voffB); PG8_STAGE(PG8_SB(1, 1), b3 + hstep, voffB); PG8_STAGE(PG8_SA(1, 0), a3, voffA);
            PG8_WAIT_V(8); PG8_WAIT_L(0); PG8_BAR; PG8_MMA(1, 0, At, B0); PG8_MMA(1, 1, At, B1); PG8_BAR; PG8_SCHED;
            } else {
            PG8_LDB(B0, 0, 0); PG8_SCHED; PG8_LDA(At, 0, 0); PG8_STAGE(PG8_SA(1, 1), a1 + hstep, voffA);
            PG8_WAIT_L(8); PG8_BAR; PG8_WAIT_L(0); PG8_MMA(0, 0, At, B0); PG8_BAR; PG8_SCHED;
            PG8_LDB(B1, 0, 1); PG8_STAGE(PG8_SB(0, 0), b2, voffB);
            PG8_BAR; PG8_WAIT_L(0); PG8_MMA(0, 1, At, B1); PG8_BAR;
            PG8_LDA(At, 0, 1); PG8_STAGE(PG8_SA(0, 0), a2, voffA);
            PG8_BAR; PG8_WAIT_L(0); PG8_MMA(1, 0, At, B0); PG8_BAR; PG8_SCHED;
            PG8_STAGE(PG8_SB(0, 1), b2 + hstep, voffB);
            PG8_WAIT_V(6); PG8_BAR; PG8_MMA(1, 1, At, B1); PG8_BAR;
            PG8_LDB(B0, 1, 0); PG8_SCHED; PG8_LDA(At, 1, 0); PG8_STAGE(PG8_SA(0, 1), a2 + hstep, voffA);
            PG8_WAIT_L(8); PG8_BAR; PG8_WAIT_L(0); PG8_MMA(0, 0, At, B0); PG8_BAR; PG8_SCHED;
            PG8_LDB(B1, 1, 1); PG8_STAGE(PG8_SB(1, 0), b3, voffB);
            PG8_BAR; PG8_WAIT_L(0); PG8_MMA(0, 1, At, B1); PG8_BAR;
            PG8_LDA(At, 1, 1); PG8_STAGE(PG8_SA(1, 0), a3, voffA);
            PG8_BAR; PG8_WAIT_L(0); PG8_MMA(1, 0, At, B0); PG8_BAR; PG8_SCHED;
            PG8_STAGE(PG8_SB(1, 1), b3 + hstep, voffB);
            PG8_WAIT_V(6); PG8_BAR; PG8_MMA(1, 1, At, B1); PG8_BAR;
            }
        }
        if constexpr (ALIGN_EPI) { if (wr == 0) PG8_BAR; }
        if constexpr (!Epi::AFTER_DRAIN) { E(acc, cur, wr, wc, fr, fq); S.done(cur); }
        if (!has_next) break;
#pragma unroll
        for (int a = 0; a < 2; ++a)
#pragma unroll
            for (int b = 0; b < 2; ++b)
#pragma unroll
                for (int m = 0; m < 4; ++m)
#pragma unroll
                    for (int n = 0; n < 2; ++n) acc[a][b][m][n] = (f32x4){0.f, 0.f, 0.f, 0.f};
        cur = nxt; cA = nA; cB = nB; ++ui;
        if constexpr (ALIGN_EPI) { if (wr == 1) PG8_BAR; }
    }
    PG8_WAIT_V(0);
    if constexpr (!ALIGN_EPI) { if (wr == 0) PG8_BAR; }
    PG8_BAR;
    if constexpr (Epi::AFTER_DRAIN) { E.fused(acc, cur, wr, wc, fr, fq, lds, wid, lane); S.done(cur); }
#undef PG8_SA
#undef PG8_SB
#undef PG8_STAGE
#undef PG8_LDA
#undef PG8_LDB
#undef PG8_MMA
#undef PG8_WAIT_V
#undef PG8_WAIT_L
#undef PG8_BAR
#undef PG8_SCHED
}
}

#define LAS __attribute__((address_space(3)))
typedef unsigned short bf16;
typedef unsigned v4u __attribute__((ext_vector_type(4)));
typedef unsigned v2u __attribute__((ext_vector_type(2)));
typedef float f32x4 __attribute__((ext_vector_type(4)));
typedef short bf16x8 __attribute__((ext_vector_type(8)));

constexpr int M = 16896, MP = 16384, D = 1024, DIN = 2048, DFF = 2816, DUP = 5632, DEPTH = 4;
constexpr float EPS = 1e-6f;
constexpr int LDS_BYTES = 147456;
constexpr size_t OUT_POOL_P = (size_t)M * D, OUT_CONV_P = OUT_POOL_P + 245760, OUT_FFN_P = OUT_CONV_P + 32768,
                 OUT_POOL_S = OUT_FFN_P + 360448, OUT_CONV_S = OUT_POOL_S + 245760, OUT_FFN_S = OUT_CONV_S + 32768, OUT_END = OUT_FFN_S + 360448;
constexpr size_t MiB = 1u << 20;
constexpr size_t WS_RS = 65536;
constexpr size_t WS_WIN = 1 * MiB, WS_WOUT = 5 * MiB, WS_WUP = 7 * MiB, WS_WDN = 18 * MiB, WS_PMT = 18 * MiB + 5767168, WS_XB = 24 * MiB;
constexpr size_t WS_Z = 57 * MiB, WS_MIXIN = 123 * MiB, WS_MIX = 156 * MiB, WS_PART = 189 * MiB;
constexpr int NS_OUT = 8, NS_DN = 11;
constexpr size_t WS_ACT = 57 * MiB, WS_HEAD = 222 * MiB, WS_TAIL = 234 * MiB, WS_END = 246 * MiB;
static_assert(WS_PMT + 4 * 16384 * 2 <= WS_XB && WS_ACT + (size_t)M * DFF * 2 <= WS_MIX && WS_HEAD + 264 * 2 * 5632 * 4 <= WS_TAIL && WS_TAIL + 264 * 2 * 5632 * 4 <= WS_END, "ws map");

struct Args { const float* in[20]; float* out; unsigned char* ws; };

#define LDS_WAIT() asm volatile("s_waitcnt lgkmcnt(0)" ::: "memory")
__device__ __forceinline__ unsigned f2bf(float f) { unsigned u = __builtin_bit_cast(unsigned, f); return (u + 0x7fffu + ((u >> 16) & 1u)) >> 16; }
__device__ __forceinline__ unsigned pk2(float lo, float hi) { unsigned r; asm("v_cvt_pk_bf16_f32 %0, %1, %2" : "=v"(r) : "v"(lo), "v"(hi)); return r; }
__device__ __forceinline__ float bflo(unsigned w) { return __uint_as_float(w << 16); }
__device__ __forceinline__ float bfhi(unsigned w) { return __uint_as_float(w & 0xffff0000u); }
__device__ __forceinline__ float wave_sum(float v) {
#pragma unroll
    for (int o = 1; o < 64; o <<= 1) v += __shfl_xor(v, o);
    return v;
}
__device__ __forceinline__ float dot4(f32x4 a) { return (a[0] * a[0] + a[1] * a[1]) + (a[2] * a[2] + a[3] * a[3]); }

__device__ __forceinline__ void transpose_item(const float* W, int K, int N, const float* gain_k0, bf16* WT, int mode, LAS float* scr, int item, int lane) {
    const int nblk = N / 32, kb = item / nblk, nb = item % nblk, k0 = 64 * kb, n0 = 32 * nb;
    { f32x4 v[8]; const int kr = lane >> 3, cc = 4 * (lane & 7);
#pragma unroll
      for (int i = 0; i < 8; ++i) v[i] = *(const f32x4*)(W + (size_t)(k0 + 8 * i + kr) * N + n0 + cc);
#pragma unroll
      for (int i = 0; i < 8; ++i) { const int kk = 8 * i + kr; const float g = gain_k0 ? gain_k0[kk] : 1.0f; LAS float* d = scr + kk * 33 + cc; d[0] = v[i][0] * g; d[1] = v[i][1] * g; d[2] = v[i][2] * g; d[3] = v[i][3] * g; } }
    LDS_WAIT(); asm volatile("" ::: "memory");
    int drow = n0;
    if (mode == 1) drow = n0 < DFF ? 256 * (n0 >> 7) + (n0 & 127) : 256 * ((n0 - DFF) >> 7) + 128 + ((n0 - DFF) & 127);
    const int c = lane & 7;
#pragma unroll
    for (int j = 0; j < 4; ++j) { const int n = (lane >> 3) + 8 * j; const LAS float* s = scr + (8 * c) * 33 + n;
        v4u o; o.x = pk2(s[0 * 33], s[1 * 33]); o.y = pk2(s[2 * 33], s[3 * 33]); o.z = pk2(s[4 * 33], s[5 * 33]); o.w = pk2(s[6 * 33], s[7 * 33]);
        *(v4u*)(WT + (size_t)(drow + n) * K + k0 + 8 * c) = o; }
    LDS_WAIT(); asm volatile("" ::: "memory");
}

__device__ __forceinline__ void convert_weights(const Args& a, int l, LAS float* scr, int gw, int NGW, int lane_) {
    const int lane = pg8::lane_id_asm(); (void)lane_;
    constexpr int I_IN = 16 * 64, I_OUT = 16 * 32, I_UP = 16 * 176, I_DN = 44 * 32, I_PM = 4 * 8, NITEMS = I_IN + I_OUT + I_UP + I_DN + I_PM;
    bf16* WIN = (bf16*)(a.ws + WS_WIN); bf16* WOUT = (bf16*)(a.ws + WS_WOUT); bf16* WUP = (bf16*)(a.ws + WS_WUP); bf16* WDN = (bf16*)(a.ws + WS_WDN); bf16* PMT = (bf16*)(a.ws + WS_PMT);
    for (int it = gw; it < NITEMS; it += NGW) {
        int r = it;
        if (r < I_IN) { const int k0 = 64 * (r / 64); transpose_item(a.in[5] + (size_t)l * D * DIN, D, DIN, a.in[12] + l * D + k0, WIN, 0, scr, r, lane); continue; } r -= I_IN;
        if (r < I_OUT) { const int k0 = 64 * (r / 32); const float* gn = k0 < 512 ? a.in[9] + l * 512 + k0 : a.in[10] + l * 512 + (k0 - 512);
            transpose_item(a.in[11] + (size_t)l * D * D, D, D, gn, WOUT, 0, scr, r, lane); continue; } r -= I_OUT;
        if (r < I_UP) { const int k0 = 64 * (r / 176); transpose_item(a.in[16] + (size_t)l * D * DUP, D, DUP, a.in[14] + l * D + k0, WUP, 1, scr, r, lane); continue; } r -= I_UP;
        if (r < I_DN) { transpose_item(a.in[18] + (size_t)l * DFF * D, DFF, D, nullptr, WDN, 0, scr, r, lane); continue; } r -= I_DN;
        const int g = r >> 3; transpose_item(a.in[6] + (size_t)(l * 4 + g) * 16384, 128, 128, nullptr, PMT + (size_t)g * 16384, 0, scr, r & 7, lane);
    }
}

__device__ __forceinline__ void x_prologue(const Args& a, int gw, int NGW, int lane_) {
    const int lane = pg8::lane_id_asm(); (void)lane_;
    bf16* XB = (bf16*)(a.ws + WS_XB); float* RS = (float*)(a.ws + WS_RS);
    for (int mb = gw; mb < M; mb += 2 * NGW) {
        f32x4 x[2][4];
#pragma unroll
        for (int r = 0; r < 2; ++r) { const int m = mb + r * NGW;
            if (m < M) { const float* src = m < MP ? a.in[0] + (size_t)m * D : a.in[1] + (size_t)(m - MP) * D;
#pragma unroll
                for (int j = 0; j < 2; ++j) { x[r][2 * j] = *(const f32x4*)(src + 8 * lane + 512 * j); x[r][2 * j + 1] = *(const f32x4*)(src + 8 * lane + 512 * j + 4); } } }
#pragma unroll
        for (int r = 0; r < 2; ++r) { const int m = mb + r * NGW;
            if (m < M) { float ss = 0.f;
#pragma unroll
                for (int j = 0; j < 4; ++j) ss += dot4(x[r][j]);
                const float rs = rsqrtf(wave_sum(ss) * (1.0f / D) + EPS);
                if (lane == 0) RS[m] = rs;
#pragma unroll
                for (int j = 0; j < 2; ++j) { v4u o; o.x = pk2(x[r][2 * j][0], x[r][2 * j][1]); o.y = pk2(x[r][2 * j][2], x[r][2 * j][3]); o.z = pk2(x[r][2 * j + 1][0], x[r][2 * j + 1][1]); o.w = pk2(x[r][2 * j + 1][2], x[r][2 * j + 1][3]);
                    *(v4u*)(XB + (size_t)m * D + 8 * lane + 512 * j) = o; } } }
    }
}

__device__ __forceinline__ void unpack8(v4u q, float (&f)[8]) { f[0] = bflo(q.x); f[1] = bfhi(q.x); f[2] = bflo(q.y); f[3] = bfhi(q.y); f[4] = bflo(q.z); f[5] = bfhi(q.z); f[6] = bflo(q.w); f[7] = bfhi(q.w); }

__device__ __forceinline__ void add8(float (&s)[8], v4u q) { s[0] += bflo(q.x); s[1] += bfhi(q.x); s[2] += bflo(q.y); s[3] += bfhi(q.y); s[4] += bflo(q.z); s[5] += bfhi(q.z); s[6] += bflo(q.w); s[7] += bfhi(q.w); }
__device__ __forceinline__ void sub8(float (&s)[8], v4u q) { s[0] -= bflo(q.x); s[1] -= bfhi(q.x); s[2] -= bflo(q.y); s[3] -= bfhi(q.y); s[4] -= bflo(q.z); s[5] -= bfhi(q.z); s[6] -= bflo(q.w); s[7] -= bfhi(q.w); }
__device__ __forceinline__ v4u pack_pool(const float (&s)[8], float inv, v4u qc) {
    v4u p; p.x = pk2(s[0] * inv - bflo(qc.x), s[1] * inv - bfhi(qc.x)); p.y = pk2(s[2] * inv - bflo(qc.y), s[3] * inv - bfhi(qc.y));
    p.z = pk2(s[4] * inv - bflo(qc.z), s[5] * inv - bfhi(qc.z)); p.w = pk2(s[6] * inv - bflo(qc.w), s[7] * inv - bfhi(qc.w)); return p; }
template <int W>
__device__ __forceinline__ void pool_rows(const bf16* Z, int seqrow0, int tb, int cg, bool sample, v4u (&pool)[4], v4u (&cur)[4]) {
    constexpr int R = W + 3;
    v4u q[R];
#pragma unroll
    for (int r = 0; r < R; ++r) { const int tr = tb - (W - 1) + r; q[r] = *(const v4u*)(Z + (size_t)(seqrow0 + (tr >= 0 ? tr : 0)) * DIN + cg); if (tr < 0) q[r] = (v4u){0u, 0u, 0u, 0u}; }
    float s[8];
#pragma unroll
    for (int i = 0; i < 8; ++i) s[i] = 0.f;
#pragma unroll
    for (int r = 0; r < W; ++r) add8(s, q[r]);
#pragma unroll
    for (int i = 0; i < 4; ++i) {
        if (i > 0) { add8(s, q[W - 1 + i]); sub8(s, q[i - 1]); }
        const int t = tb + i; const int cnt = sample ? W : (t + 1 < W ? t + 1 : W);
        cur[i] = q[W - 1 + i]; pool[i] = pack_pool(s, 1.0f / (float)cnt, cur[i]);
    }
}
__device__ __forceinline__ void pool_rows_state(const bf16* Z, const float* sp, int seqrow0, int tb, int cg, int W, v4u (&pool)[4], v4u (&cur)[4]) {
#pragma unroll
    for (int i = 0; i < 4; ++i) {
        const int t = tb + i; float s[8];
#pragma unroll
        for (int k = 0; k < 8; ++k) s[k] = 0.f;
        for (int j = 0; j < W; ++j) { const int tr = t - j;
            if (tr >= 0) add8(s, *(const v4u*)(Z + (size_t)(seqrow0 + tr) * DIN + cg));
            else { const float* p = sp + (size_t)(15 + tr) * 512 + cg; const f32x4 a0 = *(const f32x4*)p, a1 = *(const f32x4*)(p + 4);
                s[0] += a0[0]; s[1] += a0[1]; s[2] += a0[2]; s[3] += a0[3]; s[4] += a1[0]; s[5] += a1[1]; s[6] += a1[2]; s[7] += a1[3]; } }
        cur[i] = *(const v4u*)(Z + (size_t)(seqrow0 + t) * DIN + cg); pool[i] = pack_pool(s, 1.0f / (float)W, cur[i]);
    }
}

__device__ __forceinline__ void mixer_phase(const Args& a, int l, int it0, int itn, int its, int lane_, LAS unsigned char* wlds  ) {
    const int lane = pg8::lane_id_asm(); (void)lane_;
    const bf16* Z = (const bf16*)(a.ws + WS_Z); bf16* MIXIN = (bf16*)(a.ws + WS_MIXIN); const bf16* PMT = (const bf16*)(a.ws + WS_PMT);
    const float* state_pool = a.in[2]; const float* state_conv = a.in[3];
    const float* pool_scale = a.in[7] + l * 512; const float* conv_w = a.in[8] + l * 3 * 512;
    const int fr = lane & 15, fq = lane >> 4;
    for (int it = it0; it < itn; it += its) {
        const int tb = it / 5, task = it - tb * 5;
        const int m0 = tb * 16; const bool sample = m0 >= MP;
        int seq, t0, T; if (!sample) { seq = m0 >> 11; t0 = m0 & 2047; T = 2048; } else { seq = (m0 - MP) >> 6; t0 = (m0 - MP) & 63; T = 64; }
        const int seqrow0 = m0 - t0;
        if (task < 4) {
            const int g = task;
            const bool last = (t0 + 16 == T);
            float* out_pool = a.out + (sample ? OUT_POOL_S : OUT_POOL_P) + (size_t)(l * 8 + seq) * 15 * 512;
            { const int cg = g * 128 + 8 * fr, tbq = t0 + 4 * fq;
              v4u pool[4], cur[4];
              if (sample && t0 == 0) pool_rows_state(Z, state_pool + (size_t)(l * 8 + seq) * 15 * 512, seqrow0, tbq, cg, 2 << g, pool, cur);
              else if (g == 0) pool_rows<2>(Z, seqrow0, tbq, cg, sample, pool, cur);
              else if (g == 1) pool_rows<4>(Z, seqrow0, tbq, cg, sample, pool, cur);
              else if (g == 2) pool_rows<8>(Z, seqrow0, tbq, cg, sample, pool, cur);
              else pool_rows<16>(Z, seqrow0, tbq, cg, sample, pool, cur);
#pragma unroll
              for (int i = 0; i < 4; ++i) {
                  *(LAS v4u*)(wlds + (4 * fq + i) * 272 + 16 * fr) = pool[i];
                  const int ti = 4 * fq + i;
                  if (last && ti >= 1) { float* op = out_pool + (size_t)(ti - 1) * 512 + cg;
                      *(f32x4*)op = (f32x4){bflo(cur[i].x), bfhi(cur[i].x), bflo(cur[i].y), bfhi(cur[i].y)}; *(f32x4*)(op + 4) = (f32x4){bflo(cur[i].z), bfhi(cur[i].z), bflo(cur[i].w), bfhi(cur[i].w)}; }
              } }
            LDS_WAIT(); asm volatile("" ::: "memory");
            bf16x8 pf[4];
#pragma unroll
            for (int ks = 0; ks < 4; ++ks) pf[ks] = *(const LAS bf16x8*)(wlds + fr * 272 + ks * 64 + fq * 16);
            f32x4 ya[8]; float ss = 0.f;
#pragma unroll
            for (int n = 0; n < 8; ++n) {
                f32x4 acc = {0.f, 0.f, 0.f, 0.f};
                const int drow = 32 * (n >> 1) + 8 * (fr >> 2) + 4 * (n & 1) + (fr & 3);
#pragma unroll
                for (int ks = 0; ks < 4; ++ks) {
                    const bf16x8 wf = *(const bf16x8*)(PMT + (size_t)g * 16384 + (size_t)drow * 128 + ks * 32 + fq * 8);
                    acc = __builtin_amdgcn_mfma_f32_16x16x32_bf16(wf, pf[ks], acc, 0, 0, 0);
                }
                const f32x4 sc = *(const f32x4*)(pool_scale + g * 128 + 32 * (n >> 1) + 8 * fq + 4 * (n & 1));
                acc = acc * sc; ya[n] = acc; ss += dot4(acc);
            }
            ss += __shfl_xor(ss, 16); ss += __shfl_xor(ss, 32);
            const float rs = rsqrtf(ss * (1.0f / 128.0f) + EPS);
#pragma unroll
            for (int np = 0; np < 4; ++np) { v4u o; o.x = pk2(ya[2 * np][0] * rs, ya[2 * np][1] * rs); o.y = pk2(ya[2 * np][2] * rs, ya[2 * np][3] * rs); o.z = pk2(ya[2 * np + 1][0] * rs, ya[2 * np + 1][1] * rs); o.w = pk2(ya[2 * np + 1][2] * rs, ya[2 * np + 1][3] * rs);
                *(v4u*)(MIXIN + (size_t)(m0 + fr) * D + g * 128 + 32 * np + 8 * fq) = o; }
            LDS_WAIT(); asm volatile("" ::: "memory");
        } else {
            const int c0 = lane * 8;
            float* out_conv = a.out + (sample ? OUT_CONV_S : OUT_CONV_P) + (size_t)(l * 8 + seq) * 2 * 512;
            float w0[8], w1[8], w2[8], cm2[8], cm1[8];
            { const f32x4 q0 = *(const f32x4*)(conv_w + c0), q1 = *(const f32x4*)(conv_w + c0 + 4); w0[0] = q0[0]; w0[1] = q0[1]; w0[2] = q0[2]; w0[3] = q0[3]; w0[4] = q1[0]; w0[5] = q1[1]; w0[6] = q1[2]; w0[7] = q1[3]; }
            { const f32x4 q0 = *(const f32x4*)(conv_w + 512 + c0), q1 = *(const f32x4*)(conv_w + 512 + c0 + 4); w1[0] = q0[0]; w1[1] = q0[1]; w1[2] = q0[2]; w1[3] = q0[3]; w1[4] = q1[0]; w1[5] = q1[1]; w1[6] = q1[2]; w1[7] = q1[3]; }
            { const f32x4 q0 = *(const f32x4*)(conv_w + 1024 + c0), q1 = *(const f32x4*)(conv_w + 1024 + c0 + 4); w2[0] = q0[0]; w2[1] = q0[1]; w2[2] = q0[2]; w2[3] = q0[3]; w2[4] = q1[0]; w2[5] = q1[1]; w2[6] = q1[2]; w2[7] = q1[3]; }
            if (t0 > 0) {
                float gc[8], u[8];
                unpack8(*(const v4u*)(Z + (size_t)(m0 - 2) * DIN + 1024 + c0), gc); unpack8(*(const v4u*)(Z + (size_t)(m0 - 2) * DIN + 1536 + c0), u);
#pragma unroll
                for (int i = 0; i < 8; ++i) cm2[i] = gc[i] * u[i];
                unpack8(*(const v4u*)(Z + (size_t)(m0 - 1) * DIN + 1024 + c0), gc); unpack8(*(const v4u*)(Z + (size_t)(m0 - 1) * DIN + 1536 + c0), u);
#pragma unroll
                for (int i = 0; i < 8; ++i) cm1[i] = gc[i] * u[i];
            } else if (sample) {
                const float* sp = state_conv + (size_t)(l * 8 + seq) * 2 * 512 + c0;
                const f32x4 a0 = *(const f32x4*)sp, a1 = *(const f32x4*)(sp + 4), b0 = *(const f32x4*)(sp + 512), b1 = *(const f32x4*)(sp + 516);
                cm2[0] = a0[0]; cm2[1] = a0[1]; cm2[2] = a0[2]; cm2[3] = a0[3]; cm2[4] = a1[0]; cm2[5] = a1[1]; cm2[6] = a1[2]; cm2[7] = a1[3];
                cm1[0] = b0[0]; cm1[1] = b0[1]; cm1[2] = b0[2]; cm1[3] = b0[3]; cm1[4] = b1[0]; cm1[5] = b1[1]; cm1[6] = b1[2]; cm1[7] = b1[3];
            } else {
#pragma unroll
                for (int i = 0; i < 8; ++i) { cm2[i] = 0.f; cm1[i] = 0.f; }
            }
#pragma unroll 1
            for (int ib = 0; ib < 16; ib += 8) {
                v4u qb[8], qc[8], qu[8];
#pragma unroll
                for (int ii = 0; ii < 8; ++ii) { const size_t row = (size_t)(m0 + ib + ii); qb[ii] = *(const v4u*)(Z + row * DIN + 512 + c0); qc[ii] = *(const v4u*)(Z + row * DIN + 1024 + c0); qu[ii] = *(const v4u*)(Z + row * DIN + 1536 + c0); }
#pragma unroll
                for (int ii = 0; ii < 8; ++ii) {
                    const int i = ib + ii, t = t0 + i; const size_t row = (size_t)(m0 + i);
                    float gb[8], gc[8], u[8], cu[8], yb[8];
                    unpack8(qb[ii], gb); unpack8(qc[ii], gc); unpack8(qu[ii], u);
                    float ss = 0.f;
#pragma unroll
                    for (int k = 0; k < 8; ++k) { cu[k] = gc[k] * u[k]; const float co = w0[k] * cm2[k] + w1[k] * cm1[k] + w2[k] * cu[k]; yb[k] = gb[k] * co; ss += yb[k] * yb[k]; }
                    ss += __shfl_xor(ss, 1); ss += __shfl_xor(ss, 2); ss += __shfl_xor(ss, 4);
                    const float rs = rsqrtf(ss * (1.0f / 64.0f) + EPS);
                    v4u o; o.x = pk2(yb[0] * rs, yb[1] * rs); o.y = pk2(yb[2] * rs, yb[3] * rs); o.z = pk2(yb[4] * rs, yb[5] * rs); o.w = pk2(yb[6] * rs, yb[7] * rs);
                    *(v4u*)(MIXIN + row * D + 512 + c0) = o;
                    if (t >= T - 2) { float* op = out_conv + (size_t)(t - (T - 2)) * 512 + c0; *(f32x4*)op = (f32x4){cu[0], cu[1], cu[2], cu[3]}; *(f32x4*)(op + 4) = (f32x4){cu[4], cu[5], cu[6], cu[7]}; }
#pragma unroll
                    for (int k = 0; k < 8; ++k) { cm2[k] = cm1[k]; cm1[k] = cu[k]; }
                }
            }
        }
    }
}

__device__ __forceinline__ void xupd_phase(const Args& a, const float* gpost, int nparts, bool final_, int gw, int NGW, int lane_, int m_lo = 0) {
    const int lane = pg8::lane_id_asm(); (void)lane_;
    const bf16* P = (const bf16*)(a.ws + WS_MIX); const float* PART = (const float*)(a.ws + WS_PART); bf16* XB = (bf16*)(a.ws + WS_XB); float* RS = (float*)(a.ws + WS_RS); const float* gfin = a.in[19];
    for (int mb = m_lo + gw; mb < M; mb += 2 * NGW) {
        float x[2][16], mx[2][16]; float ss[2] = {0.f, 0.f};
#pragma unroll
        for (int r = 0; r < 2; ++r) {
            const int m = mb + r * NGW;
            if (m < M) {
#pragma unroll
                for (int j = 0; j < 2; ++j) { float f[8]; unpack8(*(const v4u*)(XB + (size_t)m * D + 8 * lane + 512 * j), f);
#pragma unroll
                    for (int i = 0; i < 8; ++i) x[r][8 * j + i] = f[i]; }
                if (m < MP) {
#pragma unroll
                    for (int j = 0; j < 2; ++j) { float f[8]; unpack8(*(const v4u*)(P + (size_t)m * D + 8 * lane + 512 * j), f);
#pragma unroll
                        for (int i = 0; i < 8; ++i) mx[r][8 * j + i] = f[i]; }
                } else {
#pragma unroll
                    for (int i = 0; i < 16; ++i) mx[r][i] = 0.f;
                    for (int k = 0; k < nparts; ++k) {
#pragma unroll
                        for (int j = 0; j < 2; ++j) { const float* pp = PART + ((size_t)k * 512 + (m - MP)) * D + 8 * lane + 512 * j; const f32x4 p0 = *(const f32x4*)pp, p1 = *(const f32x4*)(pp + 4);
                            mx[r][8 * j + 0] += p0[0]; mx[r][8 * j + 1] += p0[1]; mx[r][8 * j + 2] += p0[2]; mx[r][8 * j + 3] += p0[3]; mx[r][8 * j + 4] += p1[0]; mx[r][8 * j + 5] += p1[1]; mx[r][8 * j + 6] += p1[2]; mx[r][8 * j + 7] += p1[3]; }
                    }
                }
#pragma unroll
                for (int i = 0; i < 16; ++i) ss[r] += mx[r][i] * mx[r][i];
            }
        }
#pragma unroll
        for (int r = 0; r < 2; ++r) {
            const int m = mb + r * NGW;
            if (m < M) {
                const float rs = rsqrtf(wave_sum(ss[r]) * (1.0f / D) + EPS);
                float ss2 = 0.f;
#pragma unroll
                for (int j = 0; j < 2; ++j) { const float* gp = gpost + 8 * lane + 512 * j; const f32x4 g0 = *(const f32x4*)gp, g1 = *(const f32x4*)(gp + 4);
#pragma unroll
                    for (int i = 0; i < 4; ++i) { x[r][8 * j + i] += mx[r][8 * j + i] * rs * g0[i]; x[r][8 * j + 4 + i] += mx[r][8 * j + 4 + i] * rs * g1[i]; } }
#pragma unroll
                for (int i = 0; i < 16; ++i) ss2 += x[r][i] * x[r][i];
                const float rs2 = rsqrtf(wave_sum(ss2) * (1.0f / D) + EPS);
                if (final_) {
#pragma unroll
                    for (int j = 0; j < 2; ++j) { const float* gp = gfin + 8 * lane + 512 * j; const f32x4 g0 = *(const f32x4*)gp, g1 = *(const f32x4*)(gp + 4); float* yo = a.out + (size_t)m * D + 8 * lane + 512 * j;
                        *(f32x4*)yo = (f32x4){x[r][8 * j + 0] * rs2 * g0[0], x[r][8 * j + 1] * rs2 * g0[1], x[r][8 * j + 2] * rs2 * g0[2], x[r][8 * j + 3] * rs2 * g0[3]};
                        *(f32x4*)(yo + 4) = (f32x4){x[r][8 * j + 4] * rs2 * g1[0], x[r][8 * j + 5] * rs2 * g1[1], x[r][8 * j + 6] * rs2 * g1[2], x[r][8 * j + 7] * rs2 * g1[3]}; }
                } else {
#pragma unroll
                    for (int j = 0; j < 2; ++j) { v4u o; o.x = pk2(x[r][8 * j + 0], x[r][8 * j + 1]); o.y = pk2(x[r][8 * j + 2], x[r][8 * j + 3]); o.z = pk2(x[r][8 * j + 4], x[r][8 * j + 5]); o.w = pk2(x[r][8 * j + 6], x[r][8 * j + 7]);
                        *(v4u*)(XB + (size_t)m * D + 8 * lane + 512 * j) = o; }
                    if (lane == 0) RS[m] = rs2;
                }
            }
        }
    }
}

__device__ __forceinline__ void fixup_block(const Args& a, int l, int blk, int c4) {
    const float* HEAD = (const float*)(a.ws + WS_HEAD); const float* TAIL = (const float*)(a.ws + WS_TAIL); bf16* ACT = (bf16*)(a.ws + WS_ACT);
    const float* cw = a.in[17] + (size_t)l * 3 * DUP; const float* state_ffn = a.in[4];
    const int pg = 256 * (c4 >> 7) + (c4 & 127), pv = pg + 128;
    const bool sample = blk >= 256, seqstart = sample || (blk & 31) == 0;
    f32x4 g2 = {0.f, 0.f, 0.f, 0.f}, g1 = g2, v2 = g2, v1 = g2;
    if (!seqstart) { const float* tp = TAIL + (size_t)(blk - 1) * 2 * DUP; g2 = *(const f32x4*)(tp + pg); g1 = *(const f32x4*)(tp + DUP + pg); v2 = *(const f32x4*)(tp + pv); v1 = *(const f32x4*)(tp + DUP + pv); }
    else if (sample) { const float* sp = state_ffn + (size_t)(l * 8 + (blk - 256)) * 2 * DUP; g2 = *(const f32x4*)(sp + c4); g1 = *(const f32x4*)(sp + DUP + c4); v2 = *(const f32x4*)(sp + DFF + c4); v1 = *(const f32x4*)(sp + DUP + DFF + c4); }
    const float* hp = HEAD + (size_t)blk * 2 * DUP;
    const f32x4 h0g = *(const f32x4*)(hp + pg), h1g = *(const f32x4*)(hp + DUP + pg), h0v = *(const f32x4*)(hp + pv), h1v = *(const f32x4*)(hp + DUP + pv);
    const f32x4 w0g = *(const f32x4*)(cw + c4), w1g = *(const f32x4*)(cw + DUP + c4), w2g = *(const f32x4*)(cw + 2 * DUP + c4);
    const f32x4 w0v = *(const f32x4*)(cw + DFF + c4), w1v = *(const f32x4*)(cw + DUP + DFF + c4), w2v = *(const f32x4*)(cw + 2 * DUP + DFF + c4);
    const f32x4 cg0 = w0g * g2 + w1g * g1 + w2g * h0g, cv0 = w0v * v2 + w1v * v1 + w2v * h0v;
    const f32x4 cg1 = w0g * g1 + w1g * h0g + w2g * h1g, cv1 = w0v * v1 + w1v * h0v + w2v * h1v;
    v2u o0, o1;
    o0.x = pk2(pg8::silu_f(cg0[0]) * cv0[0], pg8::silu_f(cg0[1]) * cv0[1]); o0.y = pk2(pg8::silu_f(cg0[2]) * cv0[2], pg8::silu_f(cg0[3]) * cv0[3]);
    o1.x = pk2(pg8::silu_f(cg1[0]) * cv1[0], pg8::silu_f(cg1[1]) * cv1[1]); o1.y = pk2(pg8::silu_f(cg1[2]) * cv1[2], pg8::silu_f(cg1[3]) * cv1[3]);
    *(v2u*)(ACT + (size_t)(64 * blk) * DFF + c4) = o0; *(v2u*)(ACT + (size_t)(64 * blk + 1) * DFF + c4) = o1;
}
template <class Sched>
__device__ __forceinline__ void fixup_for_units(const Args& a, int l, const Sched& S, int tid_, int gtid_, int NT) {
    const int tid = tid_ * 64 + pg8::lane_id_asm(), gtid = gtid_ * 512 + tid;
    pg8::Unit u; int prev = -1;
    for (int i = 0; S.next(i, u); ++i) {
        if (u.pm == prev) continue;
        prev = u.pm;
        for (int it = tid; it < 4 * 704; it += 512) { const int b = it / 704; fixup_block(a, l, 4 * u.pm + b, (it - b * 704) * 4); }
    }
    const float* TAIL = (const float*)(a.ws + WS_TAIL);
    for (int it = gtid; it < 16 * 2 * 1408; it += NT) {
        const int sq = it / 2816, r = it - sq * 2816, i = r / 1408, c4 = (r - i * 1408) * 4;
        const int blk = sq < 8 ? 32 * sq + 31 : 256 + (sq - 8);
        const int pc = c4 < DFF ? 256 * (c4 >> 7) + (c4 & 127) : 256 * ((c4 - DFF) >> 7) + 128 + ((c4 - DFF) & 127);
        const f32x4 v = *(const f32x4*)(TAIL + ((size_t)blk * 2 + i) * DUP + pc);
        *(f32x4*)(a.out + (sq < 8 ? OUT_FFN_P : OUT_FFN_S) + ((size_t)(l * 8 + (sq & 7)) * 2 + i) * DUP + c4) = v;
    }
    asm volatile("s_waitcnt vmcnt(0)" ::: "memory");
    __syncthreads();
    __builtin_amdgcn_fence(__ATOMIC_ACQUIRE, "agent");
}

#define XB_TMO      128
#define XB_XCNT(j)  (256  + 64 * (j))
#define XB_XSUB(j)  (1280 + 64 * (j))
#define XB_XGEN(j)  (2304 + 64 * (j))
#define XB_TOP      3328
#define XB_TOPGEN   3392
#define XCD_BAR_WORDS 3456
#define XB_SPIN_CAP (1u << 18)

__device__ __forceinline__ unsigned xb_ld(unsigned* p)              { return __hip_atomic_load(p, __ATOMIC_RELAXED, __HIP_MEMORY_SCOPE_AGENT); }
__device__ __forceinline__ unsigned xb_add(unsigned* p, unsigned v) { return __hip_atomic_fetch_add(p, v, __ATOMIC_RELAXED, __HIP_MEMORY_SCOPE_AGENT); }
__device__ __forceinline__ unsigned xb_xcc_id() { return (unsigned)__builtin_amdgcn_s_getreg((3 << 11) | 20) & 0xFu; }
#define XB_SPIN(cond, bar) do { unsigned _sp = 0; while (cond) { __builtin_amdgcn_s_sleep(1); \
    if ((++_sp & 255u) == 0u) { if (xb_ld(&(bar)[XB_TMO])) break; if (_sp > XB_SPIN_CAP) { atomicAdd(&(bar)[XB_TMO], 1u); break; } } } } while (0)

struct XcdBarrier {
    unsigned* bar; unsigned x; int wave;
    volatile LAS unsigned* st;
};

__device__ __forceinline__ XcdBarrier xcd_barrier_post(unsigned* bar, volatile LAS unsigned* st) {
    XcdBarrier b; b.bar = bar; b.x = xb_xcc_id(); b.st = st;
    if (__builtin_amdgcn_readfirstlane((int)threadIdx.x >> 6) == 0 && pg8::lane_id_asm() == 0) (void)xb_add(&bar[XB_XCNT(b.x)], 1u);
    return b;
}
__device__ __forceinline__ void xcd_barrier_complete(unsigned* bar, unsigned x, unsigned& nloc, unsigned& nx) {
    const unsigned G = gridDim.x * gridDim.y * gridDim.z;
    unsigned sum, cnt, mine, sp = 0u;
    for (;;) {
        sum = 0u; cnt = 0u; mine = 0u;
#pragma unroll
        for (unsigned j = 0; j < 16; ++j) { const unsigned c = xb_ld(&bar[XB_XCNT(j)]); sum += c; cnt += (c > 0u) ? 1u : 0u; mine = (j == x) ? c : mine; }
        if (sum == G) break;
        __builtin_amdgcn_s_sleep(1);
        if ((++sp & 255u) == 0u) { if (xb_ld(&bar[XB_TMO])) break; if (sp > XB_SPIN_CAP) { atomicAdd(&bar[XB_TMO], 1u); break; } }
    }
    nloc = mine > 0u ? mine : 1u; nx = cnt > 0u ? cnt : 1u;
}

__device__ __forceinline__ void xcd_barrier(const XcdBarrier& b) {
    asm volatile("s_waitcnt vmcnt(0)" ::: "memory");
    __syncthreads();
    if (b.wave == 0 && pg8::lane_id_asm() == 0) {
        unsigned* bar = b.bar;
        __builtin_amdgcn_s_waitcnt(0);
        unsigned nloc = b.st[0], nx = b.st[1];
        if (nloc == 0u) { xcd_barrier_complete(bar, b.x, nloc, nx); b.st[0] = nloc; b.st[1] = nx; }
        const unsigned old = xb_add(&bar[XB_XSUB(b.x)], 1u);
        const unsigned gen = old / nloc;
        if (old + 1u == (gen + 1u) * nloc) {
            __builtin_amdgcn_fence(__ATOMIC_RELEASE, "agent");
            asm volatile("s_waitcnt vmcnt(0)" ::: "memory");
            const unsigned og = xb_add(&bar[XB_TOP], 1u);
            const unsigned tg = og / nx;
            if (og + 1u == (tg + 1u) * nx) xb_add(&bar[XB_TOPGEN], 1u);
            else XB_SPIN(xb_ld(&bar[XB_TOPGEN]) == tg, bar);
            __builtin_amdgcn_fence(__ATOMIC_ACQUIRE, "agent");
            xb_add(&bar[XB_XGEN(b.x)], 1u);
            asm volatile("s_waitcnt vmcnt(0)" ::: "memory");
        } else {
            XB_SPIN(xb_ld(&bar[XB_XGEN(b.x)]) == gen, bar);
            __builtin_amdgcn_fence(__ATOMIC_ACQUIRE, "agent");
            asm volatile("s_waitcnt vmcnt(0)" ::: "memory");
        }
    }
    __syncthreads();
}

__device__ __forceinline__ void sub_barrier(unsigned* cnt, unsigned n, int wave) {
    asm volatile("s_waitcnt vmcnt(0)" ::: "memory");
    __syncthreads();
    if (wave == 0 && pg8::lane_id_asm() == 0) {
        __builtin_amdgcn_fence(__ATOMIC_RELEASE, "agent");
        asm volatile("s_waitcnt vmcnt(0)" ::: "memory");
        __hip_atomic_fetch_add(cnt, 1u, __ATOMIC_RELAXED, __HIP_MEMORY_SCOPE_AGENT);
        unsigned spins = 0;
        while (__hip_atomic_load(cnt, __ATOMIC_RELAXED, __HIP_MEMORY_SCOPE_AGENT) < n) { __builtin_amdgcn_s_sleep(2); if (++spins > (1u << 22)) break; }
        __builtin_amdgcn_fence(__ATOMIC_ACQUIRE, "agent");
        asm volatile("s_waitcnt vmcnt(0)" ::: "memory");
    }
    __syncthreads();
}
#define LAYER_BODY(l) do { \
        { \
          { pg8::Gemm g{XB, WIN, D}; pg8::MixedOrder S; S.init(DIN, D / 64, 0, G, bx); pg8::EpiStore E{Z, DIN, nullptr, (const float*)(a.ws + WS_RS)}; \
            pg8::gemm_phase<pg8::EpiStore, pg8::MixedOrder, true, true>(lds, g, S, E, wave); } \
          xcd_barrier(bar); \
          if (bx < 16) {   \
            { pg8::Gemm g{XB, WIN, D}; pg8::SampleOrder S; S.init(DIN, D / 64, bx); pg8::EpiStore E{Z, DIN, nullptr, (const float*)(a.ws + WS_RS)}; \
              pg8::gemm_phase<pg8::EpiStore, pg8::SampleOrder, true, true>(lds, g, S, E, wave); } \
            sub_barrier((unsigned*)a.ws + 3520 + 64 * l, 16u, wave); \
          } \
          mixer_phase(a, l, bx < 16 ? 5120 + bx * 8 + wave : (bx - 16) * 8 + wave, bx < 16 ? 5280 : 5120, bx < 16 ? 128 : 1920, 0, lds + wave * 16384); \
        } \
        xcd_barrier(bar); \
        { pg8::Gemm g{MIXIN, WOUT, D}; pg8::MixedOrder S; S.init(D, D / 64, NS_OUT, G, bx); pg8::EpiStore E{MIX, D, (float*)(a.ws + WS_PART), nullptr}; \
          pg8::gemm_phase<pg8::EpiStore, pg8::MixedOrder, true, true>(lds, g, S, E, wave); } \
        xcd_barrier(bar); \
        xupd_phase(a, a.in[13] + l * D, NS_OUT, false, gw, NGW, 0); \
        xcd_barrier(bar); \
        { pg8::Gemm g{XB, WUP, D}; pg8::MixedOrder S; S.init(DUP, D / 64, 1, G, bx); \
          pg8::EpiUp E{ACT, (float*)(a.ws + WS_HEAD), (float*)(a.ws + WS_TAIL), a.in[17] + (size_t)l * 3 * DUP, (const float*)(a.ws + WS_RS)}; \
          pg8::gemm_phase<pg8::EpiUp, pg8::MixedOrder, true, true>(lds, g, S, E, wave); } \
        xcd_barrier(bar); \
        { pg8::Gemm g{ACT, WDN, DFF}; pg8::MixedOrder S; S.init(D, DFF / 64, NS_DN, G, bx); pg8::EpiStore E{MIX, D, (float*)(a.ws + WS_PART), nullptr}; \
          fixup_for_units(a, l, S, wave, bx, G * 512); \
          pg8::gemm_phase<pg8::EpiStore, pg8::MixedOrder, true, true>(lds, g, S, E, wave); } \
        xcd_barrier(bar); \
        xupd_phase(a, a.in[15] + l * D, NS_DN, l == DEPTH - 1, gw, NGW, 0); \
        if (l + 1 < DEPTH) { convert_weights(a, l + 1, scr, gw, NGW, 0); xcd_barrier(bar); } \
 } while (0)
__global__ void __launch_bounds__(512, 2) fwd_megakernel(Args a) {
    extern __shared__ __attribute__((aligned(16))) unsigned char lds_raw[];
    LAS unsigned char* lds = (LAS unsigned char*)lds_raw;
    cg::grid_group grid = cg::this_grid();
    const int wave = __builtin_amdgcn_readfirstlane((int)threadIdx.x >> 6);
    const int G = gridDim.x, bx = blockIdx.x;
    const int vcu = (G % 8 == 0) ? (bx % 8) * (G / 8) + bx / 8 : bx;
    const int gw = vcu * 8 + wave, NGW = G * 8;
    LAS float* scr = (LAS float*)(lds + wave * 16384);
    bf16* XB = (bf16*)(a.ws + WS_XB); bf16* Z = (bf16*)(a.ws + WS_Z); bf16* MIXIN = (bf16*)(a.ws + WS_MIXIN); bf16* MIX = (bf16*)(a.ws + WS_MIX); bf16* ACT = (bf16*)(a.ws + WS_ACT);
    const bf16* WIN = (const bf16*)(a.ws + WS_WIN); const bf16* WOUT = (const bf16*)(a.ws + WS_WOUT); const bf16* WUP = (const bf16*)(a.ws + WS_WUP); const bf16* WDN = (const bf16*)(a.ws + WS_WDN);

    volatile LAS unsigned* bst = (volatile LAS unsigned*)(lds + 131072);
    if (threadIdx.x < 2) bst[threadIdx.x] = 0u;
    __syncthreads();
    XcdBarrier bar = xcd_barrier_post((unsigned*)a.ws, bst); bar.wave = wave;
    if (a.ws == nullptr) grid.sync();
    convert_weights(a, 0, scr, gw, NGW, 0);
    x_prologue(a, gw, NGW, 0);
    xcd_barrier(bar);
    LAYER_BODY(0); LAYER_BODY(1); LAYER_BODY(2); LAYER_BODY(3);
}

extern "C" void kernel_launch(void* const* d_in, const int* in_sizes, int n_in, void* d_out, int out_size, void* d_ws, size_t ws_size, hipStream_t stream) {
    static int grid = 0;
    if (grid == 0) {
        if (n_in != 20 || (size_t)out_size != OUT_END || ws_size < WS_END) { fprintf(stderr, "kernel_launch: unexpected shapes (n_in %d out %d ws %zu); nothing launched\n", n_in, out_size, ws_size); grid = -1; return; }
        int dev = 0, cus = 0, per_cu = 0;
        (void)hipGetDevice(&dev);
        (void)hipDeviceGetAttribute(&cus, hipDeviceAttributeMultiprocessorCount, dev);
        (void)hipFuncSetAttribute((const void*)fwd_megakernel, hipFuncAttributeMaxDynamicSharedMemorySize, LDS_BYTES);
        (void)hipOccupancyMaxActiveBlocksPerMultiprocessor(&per_cu, (const void*)fwd_megakernel, 512, LDS_BYTES);
        if (per_cu < 1) per_cu = 1;
        grid = cus * per_cu;
        if (grid != 256) { fprintf(stderr, "kernel_launch: this kernel's phase program is laid out for 256 resident workgroups (one per CU of a 256-CU device), got %d; nothing launched\n", grid); grid = -1; return; }
    }
    if (grid < 0) return;
    if (hipMemsetAsync(d_ws, 0, 16384, stream) != hipSuccess) { fprintf(stderr, "kernel_launch: hipMemsetAsync of the barrier words failed\n"); return; }
    Args a{};
    for (int i = 0; i < 20; ++i) a.in[i] = (const float*)d_in[i];
    a.out = (float*)d_out; a.ws = (unsigned char*)d_ws;
    void* args[] = {&a};
    hipError_t e = hipLaunchCooperativeKernel((const void*)fwd_megakernel, dim3(grid), dim3(512), args, LDS_BYTES, stream);
    if (e != hipSuccess) fprintf(stderr, "cooperative launch failed: %s (grid %d)\n", hipGetErrorString(e), grid);
}
```

```cpp
#include <hip/hip_runtime.h>
#include <hip/hip_cooperative_groups.h>
#include <cstdio>
#include <cstdint>
namespace cg = cooperative_groups;

namespace pg8 {
#define PG8_LAS __attribute__((address_space(3)))
typedef unsigned short bf16_t;
typedef short bf16x8 __attribute__((ext_vector_type(8)));
typedef float f32x4 __attribute__((ext_vector_type(4)));
typedef unsigned u32x4 __attribute__((ext_vector_type(4)));
constexpr int BM = 256, BK = 64, HALF = 128, HTB = HALF * BK * 2  , STAGE_BYTES = 8 * HTB, NXCD = 8, WGM = 8;

__host__ __device__ __forceinline__ int lds_byte(int r, int c) { const int st = (r >> 4) * 2 + (c >> 5), rr = r & 15, cc = c & 31, ob = rr * 64 + cc * 2; return st * 1024 + (ob ^ (((ob >> 9) & 1) << 5)); }
__host__ __device__ __forceinline__ void stage_rc(int b, int& R, int& C) { const int st = b / 1024, sb = b % 1024, swz = sb ^ (((sb >> 9) & 1) << 5); R = (st >> 1) * 16 + swz / 64; C = (st & 1) * 32 + (swz % 64) / 2; }
__host__ __device__ __forceinline__ int perm32(int rho) { const int n = rho >> 4, i = rho & 15; return 8 * (i >> 2) + 4 * n + (i & 3); }

__device__ __forceinline__ int lane_id_asm() { int l; asm volatile("v_mbcnt_lo_u32_b32 %0, -1, 0\n\tv_mbcnt_hi_u32_b32 %0, -1, %0" : "=v"(l)); return l; }
struct Unit { int pm, pn, ks, k0, nt; };
struct Gemm { const bf16_t* A; const bf16_t* Bt; int ld; };

struct MixedOrder {
    int nN, nP, nS, ntF, ntS, nwg, G, c;
    __host__ __device__ __forceinline__ void init(int N, int ntFull, int nSplit, int G_, int c_) { nN = N / BM; nP = 64 * nN; nS = nSplit; ntF = ntFull; ntS = nSplit ? ntFull / nSplit : 0; nwg = nP + 2 * nN * nS;   G = G_; c = c_; }
    __host__ __device__ __forceinline__ bool next(int i, Unit& u) const {
        const long L = (long)i * G + c; if (L >= nwg) return false;
        int wgid = (int)L;
        if (wgid < nP) {
            { const int q = nP / NXCD, xcd = wgid % NXCD, off = wgid / NXCD; wgid = xcd * q + off; }
            const int nig = WGM * nN, gid = wgid / nig, fm = gid * WGM;
            u.pm = fm + ((wgid % nig) % WGM); u.pn = (wgid % nig) / WGM; u.ks = 0; u.k0 = 0; u.nt = ntF;
        } else {
            wgid -= nP; u.ks = wgid % nS; const int t = wgid / nS; u.pm = 64 + t / nN; u.pn = t % nN; u.k0 = u.ks * ntS; u.nt = ntS;
        }
        return true;
    }
    __device__ __forceinline__ void a_ready(const Unit&) const {}
    __device__ __forceinline__ void done(const Unit&) const {}
};

struct SampleOrder {
    int nN, ntF, c;
    __host__ __device__ __forceinline__ void init(int N, int ntFull, int c_) { nN = N / BM; ntF = ntFull; c = c_; }
    __host__ __device__ __forceinline__ bool next(int i, Unit& u) const { if (i != 0 || c >= 2 * nN) return false; u.pm = 64 + c / nN; u.pn = c % nN; u.ks = 0; u.k0 = 0; u.nt = ntF; return true; }
    __device__ __forceinline__ void a_ready(const Unit&) const {}
    __device__ __forceinline__ void done(const Unit&) const {}
};
__device__ __forceinline__ unsigned cvt_pk_bf16(float lo, float hi) { unsigned r; asm volatile("v_cvt_pk_bf16_f32 %0, %1, %2" : "=v"(r) : "v"(lo), "v"(hi)); return r; }

struct EpiStore {
    static constexpr bool PERM = true, AFTER_DRAIN = false, APERM = false;
    bf16_t* O; int ldc; float* PART; const float* rs;
    __device__ __forceinline__ void operator()(const f32x4 (&acc)[2][2][4][2], const Unit& u, int wr, int wc, int fr, int fq) const {
        const int row0 = u.pm * BM + wr * 64 + fr, col0 = u.pn * BM + wc * 32 + 8 * fq;
        if (PART != nullptr && u.pm >= 64) {
            float* base = PART + (size_t)u.ks * 512 * ldc;
#pragma unroll
            for (int ai = 0; ai < 2; ++ai)
#pragma unroll
                for (int m = 0; m < 4; ++m) { float* rowp = base + (size_t)(row0 - 16384 + ai * HALF + m * 16) * ldc + col0;
#pragma unroll
                    for (int bj = 0; bj < 2; ++bj) { *(f32x4*)(rowp + bj * HALF) = acc[ai][bj][m][0]; *(f32x4*)(rowp + bj * HALF + 4) = acc[ai][bj][m][1]; } }
            return;
        }
#pragma unroll
        for (int ai = 0; ai < 2; ++ai)
#pragma unroll
            for (int m = 0; m < 4; ++m) { bf16_t* rowp = O + (size_t)(row0 + ai * HALF + m * 16) * ldc + col0; const float r = rs ? rs[row0 + ai * HALF + m * 16] : 1.0f;
#pragma unroll
                for (int bj = 0; bj < 2; ++bj) { const f32x4 v0 = acc[ai][bj][m][0] * r, v1 = acc[ai][bj][m][1] * r;
                    u32x4 w; w.x = cvt_pk_bf16(v0[0], v0[1]); w.y = cvt_pk_bf16(v0[2], v0[3]); w.z = cvt_pk_bf16(v1[0], v1[1]); w.w = cvt_pk_bf16(v1[2], v1[3]);
                    *(u32x4*)(rowp + bj * HALF) = w; } }
    }
};

__device__ __forceinline__ float silu_f(float x) { return x * __builtin_amdgcn_rcpf(1.0f + __expf(-x)); }

struct EpiUp {
    static constexpr bool PERM = true, AFTER_DRAIN = false, APERM = true;
    bf16_t* ACT; float* HEAD; float* TAIL; const float* cw; const float* rs;
    typedef float f32x2 __attribute__((ext_vector_type(2)));
    static __device__ __forceinline__ f32x2 shr1(f32x2 v) { const int l = lane_id_asm(); const int src = (l & 48) | ((l + 15) & 15); f32x2 r; r.x = __shfl(v.x, src); r.y = __shfl(v.y, src); return r; }
    __device__ __forceinline__ void operator()(f32x4 (&acc)[2][2][4][2], const Unit& u, int wr, int wc, int fr, int fq) const {
        { float rr[2][4];
#pragma unroll
          for (int ai = 0; ai < 2; ++ai)
#pragma unroll
              for (int m = 0; m < 4; ++m) rr[ai][m] = rs[u.pm * BM + ai * HALF + wr * 64 + 4 * fr + m];
#pragma unroll
          for (int ai = 0; ai < 2; ++ai)
#pragma unroll
              for (int m = 0; m < 4; ++m)
#pragma unroll
                  for (int bj = 0; bj < 2; ++bj) { acc[ai][bj][m][0] *= rr[ai][m]; acc[ai][bj][m][1] *= rr[ai][m]; } }
        const int chl = wc * 32 + 8 * fq, ch0 = u.pn * 128 + chl;
        f32x2 wgk[3], wvk[3], wgn[3], wvn[3];
#pragma unroll
        for (int k = 0; k < 3; ++k) { wgk[k] = *(const f32x2*)(cw + k * 5632 + ch0); wvk[k] = *(const f32x2*)(cw + k * 5632 + 2816 + ch0); }
        unsigned pw[2][4][4];
#pragma unroll
        for (int gi = 0; gi < 4; ++gi) {
            const int n = gi >> 1, j0 = 2 * (gi & 1);
            if (gi < 3) {
#pragma unroll
                for (int k = 0; k < 3; ++k) { wgn[k] = *(const f32x2*)(cw + k * 5632 + ch0 + 2 * (gi + 1)); wvn[k] = *(const f32x2*)(cw + k * 5632 + 2816 + ch0 + 2 * (gi + 1)); }
            }
#pragma unroll
            for (int ai = 0; ai < 2; ++ai) {
                f32x2 xg[4], xv[4];
#pragma unroll
                for (int m = 0; m < 4; ++m) { xg[m] = (f32x2){acc[ai][0][m][n][j0], acc[ai][0][m][n][j0 + 1]}; xv[m] = (f32x2){acc[ai][1][m][n][j0], acc[ai][1][m][n][j0 + 1]}; }
                const f32x2 g3 = shr1(xg[3]), g2 = shr1(xg[2]), v3 = shr1(xv[3]), v2 = shr1(xv[2]);
                f32x2 cg[4], cv[4];
                cg[0] = wgk[0] * g2 + wgk[1] * g3 + wgk[2] * xg[0];        cv[0] = wvk[0] * v2 + wvk[1] * v3 + wvk[2] * xv[0];
                cg[1] = wgk[0] * g3 + wgk[1] * xg[0] + wgk[2] * xg[1];     cv[1] = wvk[0] * v3 + wvk[1] * xv[0] + wvk[2] * xv[1];
                cg[2] = wgk[0] * xg[0] + wgk[1] * xg[1] + wgk[2] * xg[2];  cv[2] = wvk[0] * xv[0] + wvk[1] * xv[1] + wvk[2] * xv[2];
                cg[3] = wgk[0] * xg[1] + wgk[1] * xg[2] + wgk[2] * xg[3];  cv[3] = wvk[0] * xv[1] + wvk[1] * xv[2] + wvk[2] * xv[3];
#pragma unroll
                for (int m = 0; m < 4; ++m) {
                    const f32x2 t = cg[m] * (-1.4426950408889634f);
                    f32x2 e; e.x = __builtin_amdgcn_exp2f(t.x); e.y = __builtin_amdgcn_exp2f(t.y);
                    const f32x2 d = e + 1.0f;
                    f32x2 s; s.x = __builtin_amdgcn_rcpf(d.x); s.y = __builtin_amdgcn_rcpf(d.y);
                    const f32x2 o = (cg[m] * s) * cv[m];
                    pw[ai][m][gi] = cvt_pk_bf16(o.x, o.y);
                }
                __builtin_amdgcn_sched_barrier(0);
            }
            if (gi < 3) {
#pragma unroll
                for (int k = 0; k < 3; ++k) { wgk[k] = wgn[k]; wvk[k] = wvn[k]; }
            }
        }
#pragma unroll
        for (int ai = 0; ai < 2; ++ai) {
            const int blk = 4 * u.pm + 2 * ai + wr;
            if (fr == 0) {
#pragma unroll
                for (int m = 0; m < 2; ++m)
#pragma unroll
                    for (int bj = 0; bj < 2; ++bj)
#pragma unroll
                        for (int n = 0; n < 2; ++n) *(f32x4*)(HEAD + ((size_t)blk * 2 + m) * 5632 + u.pn * 256 + bj * 128 + chl + 4 * n) = acc[ai][bj][m][n];
            }
            if (fr == 15) {
#pragma unroll
                for (int m = 2; m < 4; ++m)
#pragma unroll
                    for (int bj = 0; bj < 2; ++bj)
#pragma unroll
                        for (int n = 0; n < 2; ++n) *(f32x4*)(TAIL + ((size_t)blk * 2 + (m - 2)) * 5632 + u.pn * 256 + bj * 128 + chl + 4 * n) = acc[ai][bj][m][n];
            }
#pragma unroll
            for (int m = 0; m < 4; ++m) {
                if (m >= 2 || fr > 0) {
                    u32x4 w; w.x = pw[ai][m][0]; w.y = pw[ai][m][1]; w.z = pw[ai][m][2]; w.w = pw[ai][m][3];
                    *(u32x4*)(ACT + (size_t)(64 * blk + 4 * fr + m) * 2816 + ch0) = w;
                }
            }
        }
    }
};

template <class Epi, class Sched, bool ALIGN_EPI = false, bool SP2 = false>
__device__ __forceinline__ void gemm_phase(PG8_LAS unsigned char* lds, const Gemm g, const Sched& S, const Epi& E, const int wave_s) {
    const int wid = wave_s, lane = lane_id_asm(), tid = wid * 64 + lane, wr = wid >> 2, wc = wid & 3, fr = lane & 15, fq = lane >> 4;
    const int K = g.ld;
    unsigned voffA[2], voffB[2];
#pragma unroll
    for (int i = 0; i < 2; ++i) { int R, C; stage_rc(tid * 16 + i * 8192, R, C); const int Rb = Epi::PERM ? ((R & ~31) + perm32(R & 31)) : R;
        const int Ra = Epi::APERM ? ((R & ~63) + 4 * (R & 15) + ((R & 63) >> 4)) : R;
        voffA[i] = (unsigned)(Ra * K + C) * 2u; voffB[i] = (unsigned)(Rb * K + C) * 2u; }
    const size_t kstep = (size_t)(BK * 2);
    const size_t hstep = (size_t)HALF * K * 2;
    const size_t tstep = 2 * hstep;
    const unsigned ldsw = (unsigned)wid * 1024u;
    const int aoff = lds_byte(wr * 64 + fr, fq * 8), boff = lds_byte(wc * 32 + fr, fq * 8);
#define PG8_SA(b, h) (((b) * 2 + (h)) * HTB)
#define PG8_SB(b, h) ((4 + (b) * 2 + (h)) * HTB)
#define PG8_STAGE(bufoff, gbase, voff) do { _Pragma("unroll") for (int _i = 0; _i < 2; ++_i) \
        __builtin_amdgcn_global_load_lds((const unsigned*)((const char*)(gbase) + (voff)[_i]), (PG8_LAS unsigned*)(lds + (bufoff) + ldsw + _i * 8192), 16, 0, 0); } while (0)
#define PG8_LDA(dst, b, h) do { _Pragma("unroll") for (int m = 0; m < 4; ++m) _Pragma("unroll") for (int k = 0; k < 2; ++k) dst[m][k] = *(const PG8_LAS bf16x8*)(lds + PG8_SA(b, h) + aoff + m * 2048 + k * 1024); } while (0)
#define PG8_LDB(dst, b, h) do { _Pragma("unroll") for (int n = 0; n < 2; ++n) _Pragma("unroll") for (int k = 0; k < 2; ++k) dst[n][k] = *(const PG8_LAS bf16x8*)(lds + PG8_SB(b, h) + boff + n * 2048 + k * 1024); } while (0)
#define PG8_MMA(ai, bj, At, Bt) do { __builtin_amdgcn_s_setprio(1); _Pragma("unroll") for (int m = 0; m < 4; ++m) _Pragma("unroll") for (int n = 0; n < 2; ++n) _Pragma("unroll") for (int k = 0; k < 2; ++k) \
        acc[ai][bj][m][n] = __builtin_amdgcn_mfma_f32_16x16x32_bf16(Bt[n][k], At[m][k], acc[ai][bj][m][n], 0, 0, 0); __builtin_amdgcn_s_setprio(0); } while (0)
#define PG8_WAIT_V(n) asm volatile("s_waitcnt vmcnt(" #n ")" ::: "memory")
#define PG8_WAIT_L(n) asm volatile("s_waitcnt lgkmcnt(" #n ")" ::: "memory")
#define PG8_BAR __builtin_amdgcn_s_barrier()
#define PG8_SCHED __builtin_amdgcn_sched_barrier(0)
    Unit cur, nxt; int ui = 0;
    if (!S.next(0, cur)) return;
    f32x4 acc[2][2][4][2];
#pragma unroll
    for (int a = 0; a < 2; ++a)
#pragma unroll
        for (int b = 0; b < 2; ++b)
#pragma unroll
            for (int m = 0; m < 4; ++m)
#pragma unroll
                for (int n = 0; n < 2; ++n) acc[a][b][m][n] = (f32x4){0.f, 0.f, 0.f, 0.f};
    bf16x8 At[4][2], B0[2][2], B1[2][2];
    const char* cA = (const char*)g.A + (size_t)cur.pm * tstep + (size_t)cur.k0 * kstep; const char* cB = (const char*)g.Bt + (size_t)cur.pn * tstep + (size_t)cur.k0 * kstep;
    S.a_ready(cur);
    if constexpr (SP2) {
        PG8_STAGE(PG8_SB(0, 0), cB, voffB); PG8_STAGE(PG8_SB(0, 1), cB + hstep, voffB); PG8_STAGE(PG8_SA(0, 0), cA, voffA); PG8_STAGE(PG8_SA(0, 1), cA + hstep, voffA);
        if (wr == 1) PG8_BAR;
        PG8_WAIT_V(2); PG8_BAR;
        PG8_STAGE(PG8_SB(1, 0), cB + kstep, voffB); PG8_STAGE(PG8_SA(1, 0), cA + kstep, voffA); PG8_STAGE(PG8_SB(1, 1), cB + hstep + kstep, voffB);
        PG8_WAIT_V(6); PG8_BAR;
    } else {
        PG8_STAGE(PG8_SB(0, 0), cB, voffB); PG8_STAGE(PG8_SA(0, 0), cA, voffA); PG8_STAGE(PG8_SB(0, 1), cB + hstep, voffB); PG8_STAGE(PG8_SA(0, 1), cA + hstep, voffA);
        if (wr == 1) PG8_BAR;
        PG8_WAIT_V(4); PG8_BAR;
        PG8_STAGE(PG8_SB(1, 0), cB + kstep, voffB); PG8_STAGE(PG8_SA(1, 0), cA + kstep, voffA); PG8_STAGE(PG8_SB(1, 1), cB + hstep + kstep, voffB);
        PG8_WAIT_V(6); PG8_BAR;
    }
    for (;;) {
        const bool has_next = S.next(ui + 1, nxt); const int nt = cur.nt;
        const char* nA = has_next ? (const char*)g.A + (size_t)nxt.pm * tstep + (size_t)nxt.k0 * kstep : cA; const char* nB = has_next ? (const char*)g.Bt + (size_t)nxt.pn * tstep + (size_t)nxt.k0 * kstep : cB;
        for (int t = 0; t < nt; t += 2) {
            const bool last = (t == nt - 2);
            const char* a1 = cA + (size_t)(t + 1) * kstep;
            const char* a2 = last ? nA : cA + (size_t)(t + 2) * kstep; const char* b2 = last ? nB : cB + (size_t)(t + 2) * kstep;
            const char* a3 = a2 + kstep; const char* b3 = b2 + kstep;
            if (last && has_next) S.a_ready(nxt);
            if constexpr (SP2) {
            PG8_LDB(B0, 0, 0); PG8_LDB(B1, 0, 1); PG8_SCHED; PG8_LDA(At, 0, 0); PG8_STAGE(PG8_SA(1, 1), a1 + hstep, voffA);
            PG8_WAIT_V(8); PG8_WAIT_L(0); PG8_BAR; PG8_MMA(0, 0, At, B0); PG8_MMA(0, 1, At, B1); PG8_BAR; PG8_SCHED;
            PG8_LDA(At, 0, 1); PG8_STAGE(PG8_SB(0, 0), b2, voffB); PG8_STAGE(PG8_SB(0, 1), b2 + hstep, voffB); PG8_STAGE(PG8_SA(0, 0), a2, voffA);
            PG8_WAIT_V(8); PG8_WAIT_L(0); PG8_BAR; PG8_MMA(1, 0, At, B0); PG8_MMA(1, 1, At, B1); PG8_BAR; PG8_SCHED;
            PG8_LDB(B0, 1, 0); PG8_LDB(B1, 1, 1); PG8_SCHED; PG8_LDA(At, 1, 0); PG8_STAGE(PG8_SA(0, 1), a2 + hstep, voffA);
            PG8_WAIT_V(8); PG8_WAIT_L(0); PG8_BAR; PG8_MMA(0, 0, At, B0); PG8_MMA(0, 1, At, B1); PG8_BAR; PG8_SCHED;
            PG8_LDA(At, 1, 1); PG8_STAGE(PG8_SB(1, 0), b3, voffB); PG8_STAGE(PG8_SB(1, 1), b3 + hstep, voffB); PG8_STAGE(PG8_SA(1, 0), a3, voffA);
            PG8_WAIT_V(8); PG8_WAIT_L(0); PG8_BAR; PG8_MMA(1, 0, At, B0); PG8_MMA(1, 1, At, B1); PG8_BAR; PG8_SCHED;
            } else {
            PG8_LDB(B0, 0, 0); PG8_SCHED; PG8_LDA(At, 0, 0); PG8_STAGE(PG8_SA(1, 1), a1 + hstep, voffA);
            PG8_WAIT_L(8); PG8_BAR; PG8_WAIT_L(0); PG8_MMA(0, 0, At, B0); PG8_BAR; PG8_SCHED;
            PG8_LDB(B1, 0, 1); PG8_STAGE(PG8_SB(0, 0), b2, voffB);
            PG8_BAR; PG8_WAIT_L(0); PG8_MMA(0, 1, At, B1); PG8_BAR;
            PG8_LDA(At, 0, 1); PG8_STAGE(PG8_SA(0, 0), a2, voffA);
            PG8_BAR; PG8_WAIT_L(0); PG8_MMA(1, 0, At, B0); PG8_BAR; PG8_SCHED;
            PG8_STAGE(PG8_SB(0, 1), b2 + hstep, voffB);
            PG8_WAIT_V(6); PG8_BAR; PG8_MMA(1, 1, At, B1); PG8_BAR;
            PG8_LDB(B0, 1, 0); PG8_SCHED; PG8_LDA(At, 1, 0); PG8_STAGE(PG8_SA(0, 1), a2 + hstep, voffA);
            PG8_WAIT_L(8); PG8_BAR; PG8_WAIT_L(0); PG8_MMA(0, 0, At, B0); PG8_BAR; PG8_SCHED;
            PG8_LDB(B1, 1, 1); PG8_STAGE(PG8_SB(1, 0), b3, voffB);
            PG8_BAR; PG8_WAIT_L(0); PG8_MMA(0, 1, At, B1); PG8_BAR;
            PG8_LDA(At, 1, 1); PG8_STAGE(PG8_SA(1, 0), a3, voffA);
            PG8_BAR; PG8_WAIT_L(0); PG8_MMA(1, 0, At, B0); PG8_BAR; PG8_SCHED;
            PG8_STAGE(PG8_SB(1, 1), b3 + hstep, voffB);
            PG8_WAIT_V(6); PG8_BAR; PG8_MMA(1, 1, At, B1); PG8_BAR;
            }
        }
        if constexpr (ALIGN_EPI) { if (wr == 0) PG8_BAR; }
        if constexpr (!Epi::AFTER_DRAIN) { E(acc, cur, wr, wc, fr, fq); S.done(cur); }
        if (!has_next) break;
#pragma unroll
        for (int a = 0; a < 2; ++a)
#pragma unroll
            for (int b = 0; b < 2; ++b)
#pragma unroll
                for (int m = 0; m < 4; ++m)
#pragma unroll
                    for (int n = 0; n < 2; ++n) acc[a][b][m][n] = (f32x4){0.f, 0.f, 0.f, 0.f};
        cur = nxt; cA = nA; cB = nB; ++ui;
        if constexpr (ALIGN_EPI) { if (wr == 1) PG8_BAR; }
    }
    PG8_WAIT_V(0);
    if constexpr (!ALIGN_EPI) { if (wr == 0) PG8_BAR; }
    PG8_BAR;
    if constexpr (Epi::AFTER_DRAIN) { E.fused(acc, cur, wr, wc, fr, fq, lds, wid, lane); S.done(cur); }
#undef PG8_SA
#undef PG8_SB
#undef PG8_STAGE
#undef PG8_LDA
#undef PG8_LDB
#undef PG8_MMA
#undef PG8_WAIT_V
#undef PG8_WAIT_L
#undef PG8_BAR
#undef PG8_SCHED
}
}

#define LAS __attribute__((address_space(3)))
typedef unsigned short bf16;
typedef unsigned v4u __attribute__((ext_vector_type(4)));
typedef unsigned v2u __attribute__((ext_vector_type(2)));
typedef float f32x4 __attribute__((ext_vector_type(4)));
typedef short bf16x8 __attribute__((ext_vector_type(8)));

constexpr int M = 16896, MP = 16384, D = 1024, DIN = 2048, DFF = 2816, DUP = 5632, DEPTH = 4;
constexpr float EPS = 1e-6f;
constexpr int LDS_BYTES = 147456;
constexpr size_t OUT_POOL_P = (size_t)M * D, OUT_CONV_P = OUT_POOL_P + 245760, OUT_FFN_P = OUT_CONV_P + 32768,
                 OUT_POOL_S = OUT_FFN_P + 360448, OUT_CONV_S = OUT_POOL_S + 245760, OUT_FFN_S = OUT_CONV_S + 32768, OUT_END = OUT_FFN_S + 360448;
constexpr size_t MiB = 1u << 20;
constexpr size_t WS_RS = 65536;
constexpr size_t WS_WIN = 1 * MiB, WS_WOUT = 5 * MiB, WS_WUP = 7 * MiB, WS_WDN = 18 * MiB, WS_PMT = 18 * MiB + 5767168, WS_XB = 24 * MiB;
constexpr size_t WS_Z = 57 * MiB, WS_MIXIN = 123 * MiB, WS_MIX = 156 * MiB, WS_PART = 189 * MiB;
constexpr int NS_OUT = 8, NS_DN = 11;
constexpr size_t WS_ACT = 57 * MiB, WS_HEAD = 222 * MiB, WS_TAIL = 234 * MiB, WS_END = 246 * MiB;
static_assert(WS_PMT + 4 * 16384 * 2 <= WS_XB && WS_ACT + (size_t)M * DFF * 2 <= WS_MIX && WS_HEAD + 264 * 2 * 5632 * 4 <= WS_TAIL && WS_TAIL + 264 * 2 * 5632 * 4 <= WS_END, "ws map");

struct Args { const float* in[20]; float* out; unsigned char* ws; };

#define LDS_WAIT() asm volatile("s_waitcnt lgkmcnt(0)" ::: "memory")
__device__ __forceinline__ unsigned f2bf(float f) { unsigned u = __builtin_bit_cast(unsigned, f); return (u + 0x7fffu + ((u >> 16) & 1u)) >> 16; }
__device__ __forceinline__ unsigned pk2(float lo, float hi) { unsigned r; asm("v_cvt_pk_bf16_f32 %0, %1, %2" : "=v"(r) : "v"(lo), "v"(hi)); return r; }
__device__ __forceinline__ float bflo(unsigned w) { return __uint_as_float(w << 16); }
__device__ __forceinline__ float bfhi(unsigned w) { return __uint_as_float(w & 0xffff0000u); }
__device__ __forceinline__ float wave_sum(float v) {
#pragma unroll
    for (int o = 1; o < 64; o <<= 1) v += __shfl_xor(v, o);
    return v;
}
__device__ __forceinline__ float dot4(f32x4 a) { return (a[0] * a[0] + a[1] * a[1]) + (a[2] * a[2] + a[3] * a[3]); }

__device__ __forceinline__ void transpose_item(const float* W, int K, int N, const float* gain_k0, bf16* WT, int mode, LAS float* scr, int item, int lane) {
    const int nblk = N / 32, kb = item / nblk, nb = item % nblk, k0 = 64 * kb, n0 = 32 * nb;
    { f32x4 v[8]; const int kr = lane >> 3, cc = 4 * (lane & 7);
#pragma unroll
      for (int i = 0; i < 8; ++i) v[i] = *(const f32x4*)(W + (size_t)(k0 + 8 * i + kr) * N + n0 + cc);
#pragma unroll
      for (int i = 0; i < 8; ++i) { const int kk = 8 * i + kr; const float g = gain_k0 ? gain_k0[kk] : 1.0f; LAS float* d = scr + kk * 33 + cc; d[0] = v[i][0] * g; d[1] = v[i][1] * g; d[2] = v[i][2] * g; d[3] = v[i][3] * g; } }
    LDS_WAIT(); asm volatile("" ::: "memory");
    int drow = n0;
    if (mode == 1) drow = n0 < DFF ? 256 * (n0 >> 7) + (n0 & 127) : 256 * ((n0 - DFF) >> 7) + 128 + ((n0 - DFF) & 127);
    const int c = lane & 7;
#pragma unroll
    for (int j = 0; j < 4; ++j) { const int n = (lane >> 3) + 8 * j; const LAS float* s = scr + (8 * c) * 33 + n;
        v4u o; o.x = pk2(s[0 * 33], s[1 * 33]); o.y = pk2(s[2 * 33], s[3 * 33]); o.z = pk2(s[4 * 33], s[5 * 33]); o.w = pk2(s[6 * 33], s[7 * 33]);
        *(v4u*)(WT + (size_t)(drow + n) * K + k0 + 8 * c) = o; }
    LDS_WAIT(); asm volatile("" ::: "memory");
}

__device__ __forceinline__ void convert_weights(const Args& a, int l, LAS float* scr, int gw, int NGW, int lane_) {
    const int lane = pg8::lane_id_asm(); (void)lane_;
    constexpr int I_IN = 16 * 64, I_OUT = 16 * 32, I_UP = 16 * 176, I_DN = 44 * 32, I_PM = 4 * 8, NITEMS = I_IN + I_OUT + I_UP + I_DN + I_PM;
    bf16* WIN = (bf16*)(a.ws + WS_WIN); bf16* WOUT = (bf16*)(a.ws + WS_WOUT); bf16* WUP = (bf16*)(a.ws + WS_WUP); bf16* WDN = (bf16*)(a.ws + WS_WDN); bf16* PMT = (bf16*)(a.ws + WS_PMT);
    for (int it = gw; it < NITEMS; it += NGW) {
        int r = it;
        if (r < I_IN) { const int k0 = 64 * (r / 64); transpose_item(a.in[5] + (size_t)l * D * DIN, D, DIN, a.in[12] + l * D + k0, WIN, 0, scr, r, lane); continue; } r -= I_IN;
        if (r < I_OUT) { const int k0 = 64 * (r / 32); const float* gn = k0 < 512 ? a.in[9] + l * 512 + k0 : a.in[10] + l * 512 + (k0 - 512);
            transpose_item(a.in[11] + (size_t)l * D * D, D, D, gn, WOUT, 0, scr, r, lane); continue; } r -= I_OUT;
        if (r < I_UP) { const int k0 = 64 * (r / 176); transpose_item(a.in[16] + (size_t)l * D * DUP, D, DUP, a.in[14] + l * D + k0, WUP, 1, scr, r, lane); continue; } r -= I_UP;
        if (r < I_DN) { transpose_item(a.in[18] + (size_t)l * DFF * D, DFF, D, nullptr, WDN, 0, scr, r, lane); continue; } r -= I_DN;
        const int g = r >> 3; transpose_item(a.in[6] + (size_t)(l * 4 + g) * 16384, 128, 128, nullptr, PMT + (size_t)g * 16384, 0, scr, r & 7, lane);
    }
}

__device__ __forceinline__ void x_prologue(const Args& a, int gw, int NGW, int lane_) {
    const int lane = pg8::lane_id_asm(); (void)lane_;
    bf16* XB = (bf16*)(a.ws + WS_XB); float* RS = (float*)(a.ws + WS_RS);
    for (int mb = gw; mb < M; mb += 2 * NGW) {
        f32x4 x[2][4];
#pragma unroll
        for (int r = 0; r < 2; ++r) { const int m = mb + r * NGW;
            if (m < M) { const float* src = m < MP ? a.in[0] + (size_t)m * D : a.in[1] + (size_t)(m - MP) * D;
#pragma unroll
                for (int j = 0; j < 2; ++j) { x[r][2 * j] = *(const f32x4*)(src + 8 * lane + 512 * j); x[r][2 * j + 1] = *(const f32x4*)(src + 8 * lane + 512 * j + 4); } } }
#pragma unroll
        for (int r = 0; r < 2; ++r) { const int m = mb + r * NGW;
            if (m < M) { float ss = 0.f;
#pragma unroll
                for (int j = 0; j < 4; ++j) ss += dot4(x[r][j]);
                const float rs = rsqrtf(wave_sum(ss) * (1.0f / D) + EPS);
                if (lane == 0) RS[m] = rs;
#pragma unroll
                for (int j = 0; j < 2; ++j) { v4u o; o.x = pk2(x[r][2 * j][0], x[r][2 * j][1]); o.y = pk2(x[r][2 * j][2], x[r][2 * j][3]); o.z = pk2(x[r][2 * j + 1][0], x[r][2 * j + 1][1]); o.w = pk2(x[r][2 * j + 1][2], x[r][2 * j + 1][3]);
                    *(v4u*)(XB + (size_t)m * D + 8 * lane + 512 * j) = o; } } }
    }
}

__device__ __forceinline__ void unpack8(v4u q, float (&f)[8]) { f[0] = bflo(q.x); f[1] = bfhi(q.x); f[2] = bflo(q.y); f[3] = bfhi(q.y); f[4] = bflo(q.z); f[5] = bfhi(q.z); f[6] = bflo(q.w); f[7] = bfhi(q.w); }

__device__ __forceinline__ void add8(float (&s)[8], v4u q) { s[0] += bflo(q.x); s[1] += bfhi(q.x); s[2] += bflo(q.y); s[3] += bfhi(q.y); s[4] += bflo(q.z); s[5] += bfhi(q.z); s[6] += bflo(q.w); s[7] += bfhi(q.w); }
__device__ __forceinline__ void sub8(float (&s)[8], v4u q) { s[0] -= bflo(q.x); s[1] -= bfhi(q.x); s[2] -= bflo(q.y); s[3] -= bfhi(q.y); s[4] -= bflo(q.z); s[5] -= bfhi(q.z); s[6] -= bflo(q.w); s[7] -= bfhi(q.w); }
__device__ __forceinline__ v4u pack_pool(const float (&s)[8], float inv, v4u qc) {
    v4u p; p.x = pk2(s[0] * inv - bflo(qc.x), s[1] * inv - bfhi(qc.x)); p.y = pk2(s[2] * inv - bflo(qc.y), s[3] * inv - bfhi(qc.y));
    p.z = pk2(s[4] * inv - bflo(qc.z), s[5] * inv - bfhi(qc.z)); p.w = pk2(s[6] * inv - bflo(qc.w), s[7] * inv - bfhi(qc.w)); return p; }
template <int W>
__device__ __forceinline__ void pool_rows(const bf16* Z, int seqrow0, int tb, int cg, bool sample, v4u (&pool)[4], v4u (&cur)[4]) {
    constexpr int R = W + 3;
    v4u q[R];
#pragma unroll
    for (int r = 0; r < R; ++r) { const int tr = tb - (W - 1) + r; q[r] = *(const v4u*)(Z + (size_t)(seqrow0 + (tr >= 0 ? tr : 0)) * DIN + cg); if (tr < 0) q[r] = (v4u){0u, 0u, 0u, 0u}; }
    float s[8];
#pragma unroll
    for (int i = 0; i < 8; ++i) s[i] = 0.f;
#pragma unroll
    for (int r = 0; r < W; ++r) add8(s, q[r]);
#pragma unroll
    for (int i = 0; i < 4; ++i) {
        if (i > 0) { add8(s, q[W - 1 + i]); sub8(s, q[i - 1]); }
        const int t = tb + i; const int cnt = sample ? W : (t + 1 < W ? t + 1 : W);
        cur[i] = q[W - 1 + i]; pool[i] = pack_pool(s, 1.0f / (float)cnt, cur[i]);
    }
}
__device__ __forceinline__ void pool_rows_state(const bf16* Z, const float* sp, int seqrow0, int tb, int cg, int W, v4u (&pool)[4], v4u (&cur)[4]) {
#pragma unroll
    for (int i = 0; i < 4; ++i) {
        const int t = tb + i; float s[8];
#pragma unroll
        for (int k = 0; k < 8; ++k) s[k] = 0.f;
        for (int j = 0; j < W; ++j) { const int tr = t - j;
            if (tr >= 0) add8(s, *(const v4u*)(Z + (size_t)(seqrow0 + tr) * DIN + cg));
            else { const float* p = sp + (size_t)(15 + tr) * 512 + cg; const f32x4 a0 = *(const f32x4*)p, a1 = *(const f32x4*)(p + 4);
                s[0] += a0[0]; s[1] += a0[1]; s[2] += a0[2]; s[3] += a0[3]; s[4] += a1[0]; s[5] += a1[1]; s[6] += a1[2]; s[7] += a1[3]; } }
        cur[i] = *(const v4u*)(Z + (size_t)(seqrow0 + t) * DIN + cg); pool[i] = pack_pool(s, 1.0f / (float)W, cur[i]);
    }
}

__device__ __forceinline__ void mixer_phase(const Args& a, int l, int it0, int itn, int its, int lane_, LAS unsigned char* wlds  ) {
    const int lane = pg8::lane_id_asm(); (void)lane_;
    const bf16* Z = (const bf16*)(a.ws + WS_Z); bf16* MIXIN = (bf16*)(a.ws + WS_MIXIN); const bf16* PMT = (const bf16*)(a.ws + WS_PMT);
    const float* state_pool = a.in[2]; const float* state_conv = a.in[3];
    const float* pool_scale = a.in[7] + l * 512; const float* conv_w = a.in[8] + l * 3 * 512;
    const int fr = lane & 15, fq = lane >> 4;
    for (int it = it0; it < itn; it += its) {
        const int tb = it / 5, task = it - tb * 5;
        const int m0 = tb * 16; const bool sample = m0 >= MP;
        int seq, t0, T; if (!sample) { seq = m0 >> 11; t0 = m0 & 2047; T = 2048; } else { seq = (m0 - MP) >> 6; t0 = (m0 - MP) & 63; T = 64; }
        const int seqrow0 = m0 - t0;
        if (task < 4) {
            const int g = task;
            const bool last = (t0 + 16 == T);
            float* out_pool = a.out + (sample ? OUT_POOL_S : OUT_POOL_P) + (size_t)(l * 8 + seq) * 15 * 512;
            { const int cg = g * 128 + 8 * fr, tbq = t0 + 4 * fq;
              v4u pool[4], cur[4];
              if (sample && t0 == 0) pool_rows_state(Z, state_pool + (size_t)(l * 8 + seq) * 15 * 512, seqrow0, tbq, cg, 2 << g, pool, cur);
              else if (g == 0) pool_rows<2>(Z, seqrow0, tbq, cg, sample, pool, cur);
              else if (g == 1) pool_rows<4>(Z, seqrow0, tbq, cg, sample, pool, cur);
              else if (g == 2) pool_rows<8>(Z, seqrow0, tbq, cg, sample, pool, cur);
              else pool_rows<16>(Z, seqrow0, tbq, cg, sample, pool, cur);
#pragma unroll
              for (int i = 0; i < 4; ++i) {
                  *(LAS v4u*)(wlds + (4 * fq + i) * 272 + 16 * fr) = pool[i];
                  const int ti = 4 * fq + i;
                  if (last && ti >= 1) { float* op = out_pool + (size_t)(ti - 1) * 512 + cg;
                      *(f32x4*)op = (f32x4){bflo(cur[i].x), bfhi(cur[i].x), bflo(cur[i].y), bfhi(cur[i].y)}; *(f32x4*)(op + 4) = (f32x4){bflo(cur[i].z), bfhi(cur[i].z), bflo(cur[i].w), bfhi(cur[i].w)}; }
              } }
            LDS_WAIT(); asm volatile("" ::: "memory");
            bf16x8 pf[4];
#pragma unroll
            for (int ks = 0; ks < 4; ++ks) pf[ks] = *(const LAS bf16x8*)(wlds + fr * 272 + ks * 64 + fq * 16);
            f32x4 ya[8]; float ss = 0.f;
#pragma unroll
            for (int n = 0; n < 8; ++n) {
                f32x4 acc = {0.f, 0.f, 0.f, 0.f};
                const int drow = 32 * (n >> 1) + 8 * (fr >> 2) + 4 * (n & 1) + (fr & 3);
#pragma unroll
                for (int ks = 0; ks < 4; ++ks) {
                    const bf16x8 wf = *(const bf16x8*)(PMT + (size_t)g * 16384 + (size_t)drow * 128 + ks * 32 + fq * 8);
                    acc = __builtin_amdgcn_mfma_f32_16x16x32_bf16(wf, pf[ks], acc, 0, 0, 0);
                }
                const f32x4 sc = *(const f32x4*)(pool_scale + g * 128 + 32 * (n >> 1) + 8 * fq + 4 * (n & 1));
                acc = acc * sc; ya[n] = acc; ss += dot4(acc);
            }
            ss += __shfl_xor(ss, 16); ss += __shfl_xor(ss, 32);
            const float rs = rsqrtf(ss * (1.0f / 128.0f) + EPS);
#pragma unroll
            for (int np = 0; np < 4; ++np) { v4u o; o.x = pk2(ya[2 * np][0] * rs, ya[2 * np][1] * rs); o.y = pk2(ya[2 * np][2] * rs, ya[2 * np][3] * rs); o.z = pk2(ya[2 * np + 1][0] * rs, ya[2 * np + 1][1] * rs); o.w = pk2(ya[2 * np + 1][2] * rs, ya[2 * np + 1][3] * rs);
                *(v4u*)(MIXIN + (size_t)(m0 + fr) * D + g * 128 + 32 * np + 8 * fq) = o; }
            LDS_WAIT(); asm volatile("" ::: "memory");
        } else {
            const int c0 = lane * 8;
            float* out_conv = a.out + (sample ? OUT_CONV_S : OUT_CONV_P) + (size_t)(l * 8 + seq) * 2 * 512;
            float w0[8], w1[8], w2[8], cm2[8], cm1[8];
            { const f32x4 q0 = *(const f32x4*)(conv_w + c0), q1 = *(const f32x4*)(conv_w + c0 + 4); w0[0] = q0[0]; w0[1] = q0[1]; w0[2] = q0[2]; w0[3] = q0[3]; w0[4] = q1[0]; w0[5] = q1[1]; w0[6] = q1[2]; w0[7] = q1[3]; }
            { const f32x4 q0 = *(const f32x4*)(conv_w + 512 + c0), q1 = *(const f32x4*)(conv_w + 512 + c0 + 4); w1[0] = q0[0]; w1[1] = q0[1]; w1[2] = q0[2]; w1[3] = q0[3]; w1[4] = q1[0]; w1[5] = q1[1]; w1[6] = q1[2]; w1[7] = q1[3]; }
            { const f32x4 q0 = *(const f32x4*)(conv_w + 1024 + c0), q1 = *(const f32x4*)(conv_w + 1024 + c0 + 4); w2[0] = q0[0]; w2[1] = q0[1]; w2[2] = q0[2]; w2[3] = q0[3]; w2[4] = q1[0]; w2[5] = q1[1]; w2[6] = q1[2]; w2[7] = q1[3]; }
            if (t0 > 0) {
                float gc[8], u[8];
                unpack8(*(const v4u*)(Z + (size_t)(m0 - 2) * DIN + 1024 + c0), gc); unpack8(*(const v4u*)(Z + (size_t)(m0 - 2) * DIN + 1536 + c0), u);
#pragma unroll
                for (int i = 0; i < 8; ++i) cm2[i] = gc[i] * u[i];
                unpack8(*(const v4u*)(Z + (size_t)(m0 - 1) * DIN + 1024 + c0), gc); unpack8(*(const v4u*)(Z + (size_t)(m0 - 1) * DIN + 1536 + c0), u);
#pragma unroll
                for (int i = 0; i < 8; ++i) cm1[i] = gc[i] * u[i];
            } else if (sample) {
                const float* sp = state_conv + (size_t)(l * 8 + seq) * 2 * 512 + c0;
                const f32x4 a0 = *(const f32x4*)sp, a1 = *(const f32x4*)(sp + 4), b0 = *(const f32x4*)(sp + 512), b1 = *(const f32x4*)(sp + 516);
                cm2[0] = a0[0]; cm2[1] = a0[1]; cm2[2] = a0[2]; cm2[3] = a0[3]; cm2[4] = a1[0]; cm2[5] = a1[1]; cm2[6] = a1[2]; cm2[7] = a1[3];
                cm1[0] = b0[0]; cm1[1] = b0[1]; cm1[2] = b0[2]; cm1[3] = b0[3]; cm1[4] = b1[0]; cm1[5] = b1[1]; cm1[6] = b1[2]; cm1[7] = b1[3];
            } else {
#pragma unroll
                for (int i = 0; i < 8; ++i) { cm2[i] = 0.f; cm1[i] = 0.f; }
            }
#pragma unroll 1
            for (int ib = 0; ib < 16; ib += 8) {
                v4u qb[8], qc[8], qu[8];
#pragma unroll
                for (int ii = 0; ii < 8; ++ii) { const size_t row = (size_t)(m0 + ib + ii); qb[ii] = *(const v4u*)(Z + row * DIN + 512 + c0); qc[ii] = *(const v4u*)(Z + row * DIN + 1024 + c0); qu[ii] = *(const v4u*)(Z + row * DIN + 1536 + c0); }
#pragma unroll
                for (int ii = 0; ii < 8; ++ii) {
                    const int i = ib + ii, t = t0 + i; const size_t row = (size_t)(m0 + i);
                    float gb[8], gc[8], u[8], cu[8], yb[8];
                    unpack8(qb[ii], gb); unpack8(qc[ii], gc); unpack8(qu[ii], u);
                    float ss = 0.f;
#pragma unroll
                    for (int k = 0; k < 8; ++k) { cu[k] = gc[k] * u[k]; const float co = w0[k] * cm2[k] + w1[k] * cm1[k] + w2[k] * cu[k]; yb[k] = gb[k] * co; ss += yb[k] * yb[k]; }
                    ss += __shfl_xor(ss, 1); ss += __shfl_xor(ss, 2); ss += __shfl_xor(ss, 4);
                    const float rs = rsqrtf(ss * (1.0f / 64.0f) + EPS);
                    v4u o; o.x = pk2(yb[0] * rs, yb[1] * rs); o.y = pk2(yb[2] * rs, yb[3] * rs); o.z = pk2(yb[4] * rs, yb[5] * rs); o.w = pk2(yb[6] * rs, yb[7] * rs);
                    *(v4u*)(MIXIN + row * D + 512 + c0) = o;
                    if (t >= T - 2) { float* op = out_conv + (size_t)(t - (T - 2)) * 512 + c0; *(f32x4*)op = (f32x4){cu[0], cu[1], cu[2], cu[3]}; *(f32x4*)(op + 4) = (f32x4){cu[4], cu[5], cu[6], cu[7]}; }
#pragma unroll
                    for (int k = 0; k < 8; ++k) { cm2[k] = cm1[k]; cm1[k] = cu[k]; }
                }
            }
        }
    }
}

__device__ __forceinline__ void xupd_phase(const Args& a, const float* gpost, int nparts, bool final_, int gw, int NGW, int lane_, int m_lo = 0) {
    const int lane = pg8::lane_id_asm(); (void)lane_;
    const bf16* P = (const bf16*)(a.ws + WS_MIX); const float* PART = (const float*)(a.ws + WS_PART); bf16* XB = (bf16*)(a.ws + WS_XB); float* RS = (float*)(a.ws + WS_RS); const float* gfin = a.in[19];
    for (int mb = m_lo + gw; mb < M; mb += 2 * NGW) {
        float x[2][16], mx[2][16]; float ss[2] = {0.f, 0.f};
#pragma unroll
        for (int r = 0; r < 2; ++r) {
            const int m = mb + r * NGW;
            if (m < M) {
#pragma unroll
                for (int j = 0; j < 2; ++j) { float f[8]; unpack8(*(const v4u*)(XB + (size_t)m * D + 8 * lane + 512 * j), f);
#pragma unroll
                    for (int i = 0; i < 8; ++i) x[r][8 * j + i] = f[i]; }
                if (m < MP) {
#pragma unroll
                    for (int j = 0; j < 2; ++j) { float f[8]; unpack8(*(const v4u*)(P + (size_t)m * D + 8 * lane + 512 * j), f);
#pragma unroll
                        for (int i = 0; i < 8; ++i) mx[r][8 * j + i] = f[i]; }
                } else {
#pragma unroll
                    for (int i = 0; i < 16; ++i) mx[r][i] = 0.f;
                    for (int k = 0; k < nparts; ++k) {
#pragma unroll
                        for (int j = 0; j < 2; ++j) { const float* pp = PART + ((size_t)k * 512 + (m - MP)) * D + 8 * lane + 512 * j; const f32x4 p0 = *(const f32x4*)pp, p1 = *(const f32x4*)(pp + 4);
                            mx[r][8 * j + 0] += p0[0]; mx[r][8 * j + 1] += p0[1]; mx[r][8 * j + 2] += p0[2]; mx[r][8 * j + 3] += p0[3]; mx[r][8 * j + 4] += p1[0]; mx[r][8 * j + 5] += p1[1]; mx[r][8 * j + 6] += p1[2]; mx[r][8 * j + 7] += p1[3]; }
                    }
                }
#pragma unroll
                for (int i = 0; i < 16; ++i) ss[r] += mx[r][i] * mx[r][i];
            }
        }
#pragma unroll
        for (int r = 0; r < 2; ++r) {
            const int m = mb + r * NGW;
            if (m < M) {
                const float rs = rsqrtf(wave_sum(ss[r]) * (1.0f / D) + EPS);
                float ss2 = 0.f;
#pragma unroll
                for (int j = 0; j < 2; ++j) { const float* gp = gpost + 8 * lane + 512 * j; const f32x4 g0 = *(const f32x4*)gp, g1 = *(const f32x4*)(gp + 4);
#pragma unroll
                    for (int i = 0; i < 4; ++i) { x[r][8 * j + i] += mx[r][8 * j + i] * rs * g0[i]; x[r][8 * j + 4 + i] += mx[r][8 * j + 4 + i] * rs * g1[i]; } }
#pragma unroll
                for (int i = 0; i < 16; ++i) ss2 += x[r][i] * x[r][i];
                const float rs2 = rsqrtf(wave_sum(ss2) * (1.0f / D) + EPS);
                if (final_) {
#pragma unroll
                    for (int j = 0; j < 2; ++j) { const float* gp = gfin + 8 * lane + 512 * j; const f32x4 g0 = *(const f32x4*)gp, g1 = *(const f32x4*)(gp + 4); float* yo = a.out + (size_t)m * D + 8 * lane + 512 * j;
                        *(f32x4*)yo = (f32x4){x[r][8 * j + 0] * rs2 * g0[0], x[r][8 * j + 1] * rs2 * g0[1], x[r][8 * j + 2] * rs2 * g0[2], x[r][8 * j + 3] * rs2 * g0[3]};
                        *(f32x4*)(yo + 4) = (f32x4){x[r][8 * j + 4] * rs2 * g1[0], x[r][8 * j + 5] * rs2 * g1[1], x[r][8 * j + 6] * rs2 * g1[2], x[r][8 * j + 7] * rs2 * g1[3]}; }
                } else {
#pragma unroll
                    for (int j = 0; j < 2; ++j) { v4u o; o.x = pk2(x[r][8 * j + 0], x[r][8 * j + 1]); o.y = pk2(x[r][8 * j + 2], x[r][8 * j + 3]); o.z = pk2(x[r][8 * j + 4], x[r][8 * j + 5]); o.w = pk2(x[r][8 * j + 6], x[r][8 * j + 7]);
                        *(v4u*)(XB + (size_t)m * D + 8 * lane + 512 * j) = o; }
                    if (lane == 0) RS[m] = rs2;
                }
            }
        }
    }
}

__device__ __forceinline__ void fixup_block(const Args& a, int l, int blk, int c4) {
    const float* HEAD = (const float*)(a.ws + WS_HEAD); const float* TAIL = (const float*)(a.ws + WS_TAIL); bf16* ACT = (bf16*)(a.ws + WS_ACT);
    const float* cw = a.in[17] + (size_t)l * 3 * DUP; const float* state_ffn = a.in[4];
    const int pg = 256 * (c4 >> 7) + (c4 & 127), pv = pg + 128;
    const bool sample = blk >= 256, seqstart = sample || (blk & 31) == 0;
    f32x4 g2 = {0.f, 0.f, 0.f, 0.f}, g1 = g2, v2 = g2, v1 = g2;
    if (!seqstart) { const float* tp = TAIL + (size_t)(blk - 1) * 2 * DUP; g2 = *(const f32x4*)(tp + pg); g1 = *(const f32x4*)(tp + DUP + pg); v2 = *(const f32x4*)(tp + pv); v1 = *(const f32x4*)(tp + DUP + pv); }
    else if (sample) { const float* sp = state_ffn + (size_t)(l * 8 + (blk - 256)) * 2 * DUP; g2 = *(const f32x4*)(sp + c4); g1 = *(const f32x4*)(sp + DUP + c4); v2 = *(const f32x4*)(sp + DFF + c4); v1 = *(const f32x4*)(sp + DUP + DFF + c4); }
    const float* hp = HEAD + (size_t)blk * 2 * DUP;
    const f32x4 h0g = *(const f32x4*)(hp + pg), h1g = *(const f32x4*)(hp + DUP + pg), h0v = *(const f32x4*)(hp + pv), h1v = *(const f32x4*)(hp + DUP + pv);
    const f32x4 w0g = *(const f32x4*)(cw + c4), w1g = *(const f32x4*)(cw + DUP + c4), w2g = *(const f32x4*)(cw + 2 * DUP + c4);
    const f32x4 w0v = *(const f32x4*)(cw + DFF + c4), w1v = *(const f32x4*)(cw + DUP + DFF + c4), w2v = *(const f32x4*)(cw + 2 * DUP + DFF + c4);
    const f32x4 cg0 = w0g * g2 + w1g * g1 + w2g * h0g, cv0 = w0v * v2 + w1v * v1 + w2v * h0v;
    const f32x4 cg1 = w0g * g1 + w1g * h0g + w2g * h1g, cv1 = w0v * v1 + w1v * h0v + w2v * h1v;
    v2u o0, o1;
    o0.x = pk2(pg8::silu_f(cg0[0]) * cv0[0], pg8::silu_f(cg0[1]) * cv0[1]); o0.y = pk2(pg8::silu_f(cg0[2]) * cv0[2], pg8::silu_f(cg0[3]) * cv0[3]);
    o1.x = pk2(pg8::silu_f(cg1[0]) * cv1[0], pg8::silu_f(cg1[1]) * cv1[1]); o1.y = pk2(pg8::silu_f(cg1[2]) * cv1[2], pg8::silu_f(cg1[3]) * cv1[3]);
    *(v2u*)(ACT + (size_t)(64 * blk) * DFF + c4) = o0; *(v2u*)(ACT + (size_t)(64 * blk + 1) * DFF + c4) = o1;
}
template <class Sched>
__device__ __forceinline__ void fixup_for_units(const Args& a, int l, const Sched& S, int tid_, int gtid_, int NT) {
    const int tid = tid_ * 64 + pg8::lane_id_asm(), gtid = gtid_ * 512 + tid;
    pg8::Unit u; int prev = -1;
    for (int i = 0; S.next(i, u); ++i) {
        if (u.pm == prev) continue;
        prev = u.pm;
        for (int it = tid; it < 4 * 704; it += 512) { const int b = it / 704; fixup_block(a, l, 4 * u.pm + b, (it - b * 704) * 4); }
    }
    const float* TAIL = (const float*)(a.ws + WS_TAIL);
    for (int it = gtid; it < 16 * 2 * 1408; it += NT) {
        const int sq = it / 2816, r = it - sq * 2816, i = r / 1408, c4 = (r - i * 1408) * 4;
        const int blk = sq < 8 ? 32 * sq + 31 : 256 + (sq - 8);
        const int pc = c4 < DFF ? 256 * (c4 >> 7) + (c4 & 127) : 256 * ((c4 - DFF) >> 7) + 128 + ((c4 - DFF) & 127);
        const f32x4 v = *(const f32x4*)(TAIL + ((size_t)blk * 2 + i) * DUP + pc);
        *(f32x4*)(a.out + (sq < 8 ? OUT_FFN_P : OUT_FFN_S) + ((size_t)(l * 8 + (sq & 7)) * 2 + i) * DUP + c4) = v;
    }
    asm volatile("s_waitcnt vmcnt(0)" ::: "memory");
    __syncthreads();
    __builtin_amdgcn_fence(__ATOMIC_ACQUIRE, "agent");
}

#define XB_TMO      128
#define XB_XCNT(j)  (256  + 64 * (j))
#define XB_XSUB(j)  (1280 + 64 * (j))
#define XB_XGEN(j)  (2304 + 64 * (j))
#define XB_TOP      3328
#define XB_TOPGEN   3392
#define XCD_BAR_WORDS 3456
#define XB_SPIN_CAP (1u << 18)

__device__ __forceinline__ unsigned xb_ld(unsigned* p)              { return __hip_atomic_load(p, __ATOMIC_RELAXED, __HIP_MEMORY_SCOPE_AGENT); }
__device__ __forceinline__ unsigned xb_add(unsigned* p, unsigned v) { return __hip_atomic_fetch_add(p, v, __ATOMIC_RELAXED, __HIP_MEMORY_SCOPE_AGENT); }
__device__ __forceinline__ unsigned xb_xcc_id() { return (unsigned)__builtin_amdgcn_s_getreg((3 << 11) | 20) & 0xFu; }
#define XB_SPIN(cond, bar) do { unsigned _sp = 0; while (cond) { __builtin_amdgcn_s_sleep(1); \
    if ((++_sp & 255u) == 0u) { if (xb_ld(&(bar)[XB_TMO])) break; if (_sp > XB_SPIN_CAP) { atomicAdd(&(bar)[XB_TMO], 1u); break; } } } } while (0)

struct XcdBarrier {
    unsigned* bar; unsigned x; int wave;
    volatile LAS unsigned* st;
};

__device__ __forceinline__ XcdBarrier xcd_barrier_post(unsigned* bar, volatile LAS unsigned* st) {
    XcdBarrier b; b.bar = bar; b.x = xb_xcc_id(); b.st = st;
    if (__builtin_amdgcn_readfirstlane((int)threadIdx.x >> 6) == 0 && pg8::lane_id_asm() == 0) (void)xb_add(&bar[XB_XCNT(b.x)], 1u);
    return b;
}
__device__ __forceinline__ void xcd_barrier_complete(unsigned* bar, unsigned x, unsigned& nloc, unsigned& nx) {
    const unsigned G = gridDim.x * gridDim.y * gridDim.z;
    unsigned sum, cnt, mine, sp = 0u;
    for (;;) {
        sum = 0u; cnt = 0u; mine = 0u;
#pragma unroll
        for (unsigned j = 0; j < 16; ++j) { const unsigned c = xb_ld(&bar[XB_XCNT(j)]); sum += c; cnt += (c > 0u) ? 1u : 0u; mine = (j == x) ? c : mine; }
        if (sum == G) break;
        __builtin_amdgcn_s_sleep(1);
        if ((++sp & 255u) == 0u) { if (xb_ld(&bar[XB_TMO])) break; if (sp > XB_SPIN_CAP) { atomicAdd(&bar[XB_TMO], 1u); break; } }
    }
    nloc = mine > 0u ? mine : 1u; nx = cnt > 0u ? cnt : 1u;
}

__device__ __forceinline__ void xcd_barrier(const XcdBarrier& b) {
    asm volatile("s_waitcnt vmcnt(0)" ::: "memory");
    __syncthreads();
    if (b.wave == 0 && pg8::lane_id_asm() == 0) {
        unsigned* bar = b.bar;
        __builtin_amdgcn_s_waitcnt(0);
        unsigned nloc = b.st[0], nx = b.st[1];
        if (nloc == 0u) { xcd_barrier_complete(bar, b.x, nloc, nx); b.st[0] = nloc; b.st[1] = nx; }
        const unsigned old = xb_add(&bar[XB_XSUB(b.x)], 1u);
        const unsigned gen = old / nloc;
        if (old + 1u == (gen + 1u) * nloc) {
            __builtin_amdgcn_fence(__ATOMIC_RELEASE, "agent");
            asm volatile("s_waitcnt vmcnt(0)" ::: "memory");
            const unsigned og = xb_add(&bar[XB_TOP], 1u);
            const unsigned tg = og / nx;
            if (og + 1u == (tg + 1u) * nx) xb_add(&bar[XB_TOPGEN], 1u);
            else XB_SPIN(xb_ld(&bar[XB_TOPGEN]) == tg, bar);
            __builtin_amdgcn_fence(__ATOMIC_ACQUIRE, "agent");
            xb_add(&bar[XB_XGEN(b.x)], 1u);
            asm volatile("s_waitcnt vmcnt(0)" ::: "memory");
        } else {
            XB_SPIN(xb_ld(&bar[XB_XGEN(b.x)]) == gen, bar);
            __builtin_amdgcn_fence(__ATOMIC_ACQUIRE, "agent");
            asm volatile("s_waitcnt vmcnt(0)" ::: "memory");
        }
    }
    __syncthreads();
}

__device__ __forceinline__ void sub_barrier(unsigned* cnt, unsigned n, int wave) {
    asm volatile("s_waitcnt vmcnt(0)" ::: "memory");
    __syncthreads();
    if (wave == 0 && pg8::lane_id_asm() == 0) {
        __builtin_amdgcn_fence(__ATOMIC_RELEASE, "agent");
        asm volatile("s_waitcnt vmcnt(0)" ::: "memory");
        __hip_atomic_fetch_add(cnt, 1u, __ATOMIC_RELAXED, __HIP_MEMORY_SCOPE_AGENT);
        unsigned spins = 0;
        while (__hip_atomic_load(cnt, __ATOMIC_RELAXED, __HIP_MEMORY_SCOPE_AGENT) < n) { __builtin_amdgcn_s_sleep(2); if (++spins > (1u << 22)) break; }
        __builtin_amdgcn_fence(__ATOMIC_ACQUIRE, "agent");
        asm volatile("s_waitcnt vmcnt(0)" ::: "memory");
    }
    __syncthreads();
}
#define LAYER_BODY(l) do { \
        { \
          { pg8::Gemm g{XB, WIN, D}; pg8::MixedOrder S; S.init(DIN, D / 64, 0, G, bx); pg8::EpiStore E{Z, DIN, nullptr, (const float*)(a.ws + WS_RS)}; \
            pg8::gemm_phase<pg8::EpiStore, pg8::MixedOrder, true, true>(lds, g, S, E, wave); } \
          xcd_barrier(bar); \
          if (bx < 16) {   \
            { pg8::Gemm g{XB, WIN, D}; pg8::SampleOrder S; S.init(DIN, D / 64, bx); pg8::EpiStore E{Z, DIN, nullptr, (const float*)(a.ws + WS_RS)}; \
              pg8::gemm_phase<pg8::EpiStore, pg8::SampleOrder, true, true>(lds, g, S, E, wave); } \
            sub_barrier((unsigned*)a.ws + 3520 + 64 * l, 16u, wave); \
          } \
          mixer_phase(a, l, bx < 16 ? 5120 + bx * 8 + wave : (bx - 16) * 8 + wave, bx < 16 ? 5280 : 5120, bx < 16 ? 128 : 1920, 0, lds + wave * 16384); \
        } \
        xcd_barrier(bar); \
        { pg8::Gemm g{MIXIN, WOUT, D}; pg8::MixedOrder S; S.init(D, D / 64, NS_OUT, G, bx); pg8::EpiStore E{MIX, D, (float*)(a.ws + WS_PART), nullptr}; \
          pg8::gemm_phase<pg8::EpiStore, pg8::MixedOrder, true, true>(lds, g, S, E, wave); } \
        xcd_barrier(bar); \
        xupd_phase(a, a.in[13] + l * D, NS_OUT, false, gw, NGW, 0); \
        xcd_barrier(bar); \
        { pg8::Gemm g{XB, WUP, D}; pg8::MixedOrder S; S.init(DUP, D / 64, 1, G, bx); \
          pg8::EpiUp E{ACT, (float*)(a.ws + WS_HEAD), (float*)(a.ws + WS_TAIL), a.in[17] + (size_t)l * 3 * DUP, (const float*)(a.ws + WS_RS)}; \
          pg8::gemm_phase<pg8::EpiUp, pg8::MixedOrder, true, true>(lds, g, S, E, wave); } \
        xcd_barrier(bar); \
        { pg8::Gemm g{ACT, WDN, DFF}; pg8::MixedOrder S; S.init(D, DFF / 64, NS_DN, G, bx); pg8::EpiStore E{MIX, D, (float*)(a.ws + WS_PART), nullptr}; \
          fixup_for_units(a, l, S, wave, bx, G * 512); \
          pg8::gemm_phase<pg8::EpiStore, pg8::MixedOrder, true, true>(lds, g, S, E, wave); } \
        xcd_barrier(bar); \
        xupd_phase(a, a.in[15] + l * D, NS_DN, l == DEPTH - 1, gw, NGW, 0); \
        if (l + 1 < DEPTH) { convert_weights(a, l + 1, scr, gw, NGW, 0); xcd_barrier(bar); } \
 } while (0)
__global__ void __launch_bounds__(512, 2) fwd_megakernel(Args a) {
    extern __shared__ __attribute__((aligned(16))) unsigned char lds_raw[];
    LAS unsigned char* lds = (LAS unsigned char*)lds_raw;
    cg::grid_group grid = cg::this_grid();
    const int wave = __builtin_amdgcn_readfirstlane((int)threadIdx.x >> 6);
    const int G = gridDim.x, bx = blockIdx.x;
    const int vcu = (G % 8 == 0) ? (bx % 8) * (G / 8) + bx / 8 : bx;
    const int gw = vcu * 8 + wave, NGW = G * 8;
    LAS float* scr = (LAS float*)(lds + wave * 16384);
    bf16* XB = (bf16*)(a.ws + WS_XB); bf16* Z = (bf16*)(a.ws + WS_Z); bf16* MIXIN = (bf16*)(a.ws + WS_MIXIN); bf16* MIX = (bf16*)(a.ws + WS_MIX); bf16* ACT = (bf16*)(a.ws + WS_ACT);
    const bf16* WIN = (const bf16*)(a.ws + WS_WIN); const bf16* WOUT = (const bf16*)(a.ws + WS_WOUT); const bf16* WUP = (const bf16*)(a.ws + WS_WUP); const bf16* WDN = (const bf16*)(a.ws + WS_WDN);

    volatile LAS unsigned* bst = (volatile LAS unsigned*)(lds + 131072);
    if (threadIdx.x < 2) bst[threadIdx.x] = 0u;
    __syncthreads();
    XcdBarrier bar = xcd_barrier_post((unsigned*)a.ws, bst); bar.wave = wave;
    if (a.ws == nullptr) grid.sync();
    convert_weights(a, 0, scr, gw, NGW, 0);
    x_prologue(a, gw, NGW, 0);
    xcd_barrier(bar);
    LAYER_BODY(0); LAYER_BODY(1); LAYER_BODY(2); LAYER_BODY(3);
}

extern "C" void kernel_launch(void* const* d_in, const int* in_sizes, int n_in, void* d_out, int out_size, void* d_ws, size_t ws_size, hipStream_t stream) {
    static int grid = 0;
    if (grid == 0) {
        if (n_in != 20 || (size_t)out_size != OUT_END || ws_size < WS_END) { fprintf(stderr, "kernel_launch: unexpected shapes (n_in %d out %d ws %zu); nothing launched\n", n_in, out_size, ws_size); grid = -1; return; }
        int dev = 0, cus = 0, per_cu = 0;
        (void)hipGetDevice(&dev);
        (void)hipDeviceGetAttribute(&cus, hipDeviceAttributeMultiprocessorCount, dev);
        (void)hipFuncSetAttribute((const void*)fwd_megakernel, hipFuncAttributeMaxDynamicSharedMemorySize, LDS_BYTES);
        (void)hipOccupancyMaxActiveBlocksPerMultiprocessor(&per_cu, (const void*)fwd_megakernel, 512, LDS_BYTES);
        if (per_cu < 1) per_cu = 1;
        grid = cus * per_cu;
        if (grid != 256) { fprintf(stderr, "kernel_launch: this kernel's phase program is laid out for 256 resident workgroups (one per CU of a 256-CU device), got %d; nothing launched\n", grid); grid = -1; return; }
    }
    if (grid < 0) return;
    if (hipMemsetAsync(d_ws, 0, 16384, stream) != hipSuccess) { fprintf(stderr, "kernel_launch: hipMemsetAsync of the barrier words failed\n"); return; }
    Args a{};
    for (int i = 0; i < 20; ++i) a.in[i] = (const float*)d_in[i];
    a.out = (float*)d_out; a.ws = (unsigned char*)d_ws;
    void* args[] = {&a};
    hipError_t e = hipLaunchCooperativeKernel((const void*)fwd_megakernel, dim3(grid), dim3(512), args, LDS_BYTES, stream);
    if (e != hipSuccess) fprintf(stderr, "cooperative launch failed: %s (grid %d)\n", hipGetErrorString(e), grid);
}
```

```cpp
#include <hip/hip_runtime.h>
#include <hip/hip_cooperative_groups.h>
#include <cstdio>
#include <cstdint>
namespace cg = cooperative_groups;

namespace pg8 {
#define PG8_LAS __attribute__((address_space(3)))
typedef unsigned short bf16_t;
typedef short bf16x8 __attribute__((ext_vector_type(8)));
typedef float f32x4 __attribute__((ext_vector_type(4)));
typedef unsigned u32x4 __attribute__((ext_vector_type(4)));
constexpr int BM = 256, BK = 64, HALF = 128, HTB = HALF * BK * 2  , STAGE_BYTES = 8 * HTB, NXCD = 8, WGM = 8;

__host__ __device__ __forceinline__ int lds_byte(int r, int c) { const int st = (r >> 4) * 2 + (c >> 5), rr = r & 15, cc = c & 31, ob = rr * 64 + cc * 2; return st * 1024 + (ob ^ (((ob >> 9) & 1) << 5)); }
__host__ __device__ __forceinline__ void stage_rc(int b, int& R, int& C) { const int st = b / 1024, sb = b % 1024, swz = sb ^ (((sb >> 9) & 1) << 5); R = (st >> 1) * 16 + swz / 64; C = (st & 1) * 32 + (swz % 64) / 2; }
__host__ __device__ __forceinline__ int perm32(int rho) { const int n = rho >> 4, i = rho & 15; return 8 * (i >> 2) + 4 * n + (i & 3); }

__device__ __forceinline__ int lane_id_asm() { int l; asm volatile("v_mbcnt_lo_u32_b32 %0, -1, 0\n\tv_mbcnt_hi_u32_b32 %0, -1, %0" : "=v"(l)); return l; }
struct Unit { int pm, pn, ks, k0, nt; };
struct Gemm { const bf16_t* A; const bf16_t* Bt; int ld; };

struct MixedOrder {
    int nN, nP, nS, ntF, ntS, nwg, G, c;
    __host__ __device__ __forceinline__ void init(int N, int ntFull, int nSplit, int G_, int c_) { nN = N / BM; nP = 64 * nN; nS = nSplit; ntF = ntFull; ntS = nSplit ? ntFull / nSplit : 0; nwg = nP + 2 * nN * nS;   G = G_; c = c_; }
    __host__ __device__ __forceinline__ bool next(int i, Unit& u) const {
        const long L = (long)i * G + c; if (L >= nwg) return false;
        int wgid = (int)L;
        if (wgid < nP) {
            { const int q = nP / NXCD, xcd = wgid % NXCD, off = wgid / NXCD; wgid = xcd * q + off; }
            const int nig = WGM * nN, gid = wgid / nig, fm = gid * WGM;
            u.pm = fm + ((wgid % nig) % WGM); u.pn = (wgid % nig) / WGM; u.ks = 0; u.k0 = 0; u.nt = ntF;
        } else {
            wgid -= nP; u.ks = wgid % nS; const int t = wgid / nS; u.pm = 64 + t / nN; u.pn = t % nN; u.k0 = u.ks * ntS; u.nt = ntS;
        }
        return true;
    }
    __device__ __forceinline__ void a_ready(const Unit&) const {}
    __device__ __forceinline__ void done(const Unit&) const {}
};

struct SampleOrder {
    int nN, ntF, c;
    __host__ __device__ __forceinline__ void init(int N, int ntFull, int c_) { nN = N / BM; ntF = ntFull; c = c_; }
    __host__ __device__ __forceinline__ bool next(int i, Unit& u) const { if (i != 0 || c >= 2 * nN) return false; u.pm = 64 + c / nN; u.pn = c % nN; u.ks = 0; u.k0 = 0; u.nt = ntF; return true; }
    __device__ __forceinline__ void a_ready(const Unit&) const {}
    __device__ __forceinline__ void done(const Unit&) const {}
};
__device__ __forceinline__ unsigned cvt_pk_bf16(float lo, float hi) { unsigned r; asm volatile("v_cvt_pk_bf16_f32 %0, %1, %2" : "=v"(r) : "v"(lo), "v"(hi)); return r; }

struct EpiStore {
    static constexpr bool PERM = true, AFTER_DRAIN = false, APERM = false;
    bf16_t* O; int ldc; float* PART; const float* rs;
    __device__ __forceinline__ void operator()(const f32x4 (&acc)[2][2][4][2], const Unit& u, int wr, int wc, int fr, int fq) const {
        const int row0 = u.pm * BM + wr * 64 + fr, col0 = u.pn * BM + wc * 32 + 8 * fq;
        if (PART != nullptr && u.pm >= 64) {
            float* base = PART + (size_t)u.ks * 512 * ldc;
#pragma unroll
            for (int ai = 0; ai < 2; ++ai)
#pragma unroll
                for (int m = 0; m < 4; ++m) { float* rowp = base + (size_t)(row0 - 16384 + ai * HALF + m * 16) * ldc + col0;
#pragma unroll
                    for (int bj = 0; bj < 2; ++bj) { *(f32x4*)(rowp + bj * HALF) = acc[ai][bj][m][0]; *(f32x4*)(rowp + bj * HALF + 4) = acc[ai][bj][m][1]; } }
            return;
        }
#pragma unroll
        for (int ai = 0; ai < 2; ++ai)
#pragma unroll
            for (int m = 0; m < 4; ++m) { bf16_t* rowp = O + (size_t)(row0 + ai * HALF + m * 16) * ldc + col0; const float r = rs ? rs[row0 + ai * HALF + m * 16] : 1.0f;
#pragma unroll
                for (int bj = 0; bj < 2; ++bj) { const f32x4 v0 = acc[ai][bj][m][0] * r, v1 = acc[ai][bj][m][1] * r;
                    u32x4 w; w.x = cvt_pk_bf16(v0[0], v0[1]); w.y = cvt_pk_bf16(v0[2], v0[3]); w.z = cvt_pk_bf16(v1[0], v1[1]); w.w = cvt_pk_bf16(v1[2], v1[3]);
                    *(u32x4*)(rowp + bj * HALF) = w; } }
    }
};

__device__ __forceinline__ float silu_f(float x) { return x * __builtin_amdgcn_rcpf(1.0f + __expf(-x)); }

struct EpiUp {
    static constexpr bool PERM = true, AFTER_DRAIN = false, APERM = true;
    bf16_t* ACT; float* HEAD; float* TAIL; const float* cw; const float* rs;
    typedef float f32x2 __attribute__((ext_vector_type(2)));
    static __device__ __forceinline__ f32x2 shr1(f32x2 v, int src4) {
        (void)src4; const float a = v.x, b = v.y;
        f32x2 r; r.x = __int_as_float(__builtin_amdgcn_update_dpp(0, __float_as_int(a), 0x121, 0xf, 0xf, false)); r.y = __int_as_float(__builtin_amdgcn_update_dpp(0, __float_as_int(b), 0x121, 0xf, 0xf, false)); return r; }
    __device__ __forceinline__ void operator()(f32x4 (&acc)[2][2][4][2], const Unit& u, int wr, int wc, int fr, int fq) const {
        { float rr[2][4];
#pragma unroll
          for (int ai = 0; ai < 2; ++ai)
#pragma unroll
              for (int m = 0; m < 4; ++m) rr[ai][m] = rs[u.pm * BM + ai * HALF + wr * 64 + 4 * fr + m];
#pragma unroll
          for (int ai = 0; ai < 2; ++ai)
#pragma unroll
              for (int m = 0; m < 4; ++m)
#pragma unroll
                  for (int bj = 0; bj < 2; ++bj) { acc[ai][bj][m][0] *= rr[ai][m]; acc[ai][bj][m][1] *= rr[ai][m]; } }
        const int chl = wc * 32 + 8 * fq, ch0 = u.pn * 128 + chl;
        const int src4 = 4 * ((16 * fq) | ((fr + 15) & 15));
        f32x2 wgk[3], wvk[3], wgn[3], wvn[3];
#pragma unroll
        for (int k = 0; k < 3; ++k) { wgk[k] = *(const f32x2*)(cw + k * 5632 + ch0); wvk[k] = *(const f32x2*)(cw + k * 5632 + 2816 + ch0); }
        unsigned pw[2][4][4];
#pragma unroll
        for (int gi = 0; gi < 4; ++gi) {
            const int n = gi >> 1, j0 = 2 * (gi & 1);
            if (gi < 3) {
#pragma unroll
                for (int k = 0; k < 3; ++k) { wgn[k] = *(const f32x2*)(cw + k * 5632 + ch0 + 2 * (gi + 1)); wvn[k] = *(const f32x2*)(cw + k * 5632 + 2816 + ch0 + 2 * (gi + 1)); }
            }
#pragma unroll
            for (int ai = 0; ai < 2; ++ai) {
                f32x2 xg[4], xv[4];
#pragma unroll
                for (int m = 0; m < 4; ++m) { xg[m] = (f32x2){acc[ai][0][m][n][j0], acc[ai][0][m][n][j0 + 1]}; xv[m] = (f32x2){acc[ai][1][m][n][j0], acc[ai][1][m][n][j0 + 1]}; }
                const f32x2 g3 = shr1(xg[3], src4), g2 = shr1(xg[2], src4), v3 = shr1(xv[3], src4), v2 = shr1(xv[2], src4);
                f32x2 cg[4], cv[4];
                cg[0] = wgk[0] * g2 + wgk[1] * g3 + wgk[2] * xg[0];        cv[0] = wvk[0] * v2 + wvk[1] * v3 + wvk[2] * xv[0];
                cg[1] = wgk[0] * g3 + wgk[1] * xg[0] + wgk[2] * xg[1];     cv[1] = wvk[0] * v3 + wvk[1] * xv[0] + wvk[2] * xv[1];
                cg[2] = wgk[0] * xg[0] + wgk[1] * xg[1] + wgk[2] * xg[2];  cv[2] = wvk[0] * xv[0] + wvk[1] * xv[1] + wvk[2] * xv[2];
                cg[3] = wgk[0] * xg[1] + wgk[1] * xg[2] + wgk[2] * xg[3];  cv[3] = wvk[0] * xv[1] + wvk[1] * xv[2] + wvk[2] * xv[3];
#pragma unroll
                for (int m = 0; m < 4; ++m) {
                    const f32x2 t = cg[m] * (-1.4426950408889634f);
                    f32x2 e; e.x = __builtin_amdgcn_exp2f(t.x); e.y = __builtin_amdgcn_exp2f(t.y);
                    const f32x2 d = e + 1.0f;
                    f32x2 s; s.x = __builtin_amdgcn_rcpf(d.x); s.y = __builtin_amdgcn_rcpf(d.y);
                    const f32x2 o = (cg[m] * s) * cv[m];
                    pw[ai][m][gi] = cvt_pk_bf16(o.x, o.y);
                }
                __builtin_amdgcn_sched_barrier(0);
            }
            if (gi < 3) {
#pragma unroll
                for (int k = 0; k < 3; ++k) { wgk[k] = wgn[k]; wvk[k] = wvn[k]; }
            }
        }
#pragma unroll
        for (int ai = 0; ai < 2; ++ai) {
            const int blk = 4 * u.pm + 2 * ai + wr;
            if (fr == 0) {
#pragma unroll
                for (int m = 0; m < 2; ++m)
#pragma unroll
                    for (int bj = 0; bj < 2; ++bj)
#pragma unroll
                        for (int n = 0; n < 2; ++n) *(f32x4*)(HEAD + ((size_t)blk * 2 + m) * 5632 + u.pn * 256 + bj * 128 + chl + 4 * n) = acc[ai][bj][m][n];
            }
            if (fr == 15) {
#pragma unroll
                for (int m = 2; m < 4; ++m)
#pragma unroll
                    for (int bj = 0; bj < 2; ++bj)
#pragma unroll
                        for (int n = 0; n < 2; ++n) *(f32x4*)(TAIL + ((size_t)blk * 2 + (m - 2)) * 5632 + u.pn * 256 + bj * 128 + chl + 4 * n) = acc[ai][bj][m][n];
            }
#pragma unroll
            for (int m = 0; m < 4; ++m) {
                if (m >= 2 || fr > 0) {
                    u32x4 w; w.x = pw[ai][m][0]; w.y = pw[ai][m][1]; w.z = pw[ai][m][2]; w.w = pw[ai][m][3];
                    *(u32x4*)(ACT + (size_t)(64 * blk + 4 * fr + m) * 2816 + ch0) = w;
                }
            }
        }
    }
};

template <class Epi, class Sched, bool ALIGN_EPI = false, bool SP2 = false>
__device__ __forceinline__ void gemm_phase(PG8_LAS unsigned char* lds, const Gemm g, const Sched& S, const Epi& E, const int wave_s) {
    const int wid = wave_s, lane = lane_id_asm(), tid = wid * 64 + lane, wr = wid >> 2, wc = wid & 3, fr = lane & 15, fq = lane >> 4;
    const int K = g.ld;
    unsigned voffA[2], voffB[2];
#pragma unroll
    for (int i = 0; i < 2; ++i) { int R, C; stage_rc(tid * 16 + i * 8192, R, C); const int Rb = Epi::PERM ? ((R & ~31) + perm32(R & 31)) : R;
        const int Ra = Epi::APERM ? ((R & ~63) + 4 * (R & 15) + ((R & 63) >> 4)) : R;
        voffA[i] = (unsigned)(Ra * K + C) * 2u; voffB[i] = (unsigned)(Rb * K + C) * 2u; }
    const size_t kstep = (size_t)(BK * 2);
    const size_t hstep = (size_t)HALF * K * 2;
    const size_t tstep = 2 * hstep;
    const unsigned ldsw = (unsigned)wid * 1024u;
    const int aoff = lds_byte(wr * 64 + fr, fq * 8), boff = lds_byte(wc * 32 + fr, fq * 8);
#define PG8_SA(b, h) (((b) * 2 + (h)) * HTB)
#define PG8_SB(b, h) ((4 + (b) * 2 + (h)) * HTB)
#define PG8_STAGE(bufoff, gbase, voff) do { _Pragma("unroll") for (int _i = 0; _i < 2; ++_i) \
        __builtin_amdgcn_global_load_lds((const unsigned*)((const char*)(gbase) + (voff)[_i]), (PG8_LAS unsigned*)(lds + (bufoff) + ldsw + _i * 8192), 16, 0, 0); } while (0)
#define PG8_LDA(dst, b, h) do { _Pragma("unroll") for (int m = 0; m < 4; ++m) _Pragma("unroll") for (int k = 0; k < 2; ++k) dst[m][k] = *(const PG8_LAS bf16x8*)(lds + PG8_SA(b, h) + aoff + m * 2048 + k * 1024); } while (0)
#define PG8_LDB(dst, b, h) do { _Pragma("unroll") for (int n = 0; n < 2; ++n) _Pragma("unroll") for (int k = 0; k < 2; ++k) dst[n][k] = *(const PG8_LAS bf16x8*)(lds + PG8_SB(b, h) + boff + n * 2048 + k * 1024); } while (0)
#define PG8_MMA(ai, bj, At, Bt) do { __builtin_amdgcn_s_setprio(1); _Pragma("unroll") for (int m = 0; m < 4; ++m) _Pragma("unroll") for (int n = 0; n < 2; ++n) _Pragma("unroll") for (int k = 0; k < 2; ++k) \
        acc[ai][bj][m][n] = __builtin_amdgcn_mfma_f32_16x16x32_bf16(Bt[n][k], At[m][k], acc[ai][bj][m][n], 0, 0, 0); __builtin_amdgcn_s_setprio(0); } while (0)
#define PG8_WAIT_V(n) asm volatile("s_waitcnt vmcnt(" #n ")" ::: "memory")
#define PG8_WAIT_L(n) asm volatile("s_waitcnt lgkmcnt(" #n ")" ::: "memory")
#define PG8_BAR __builtin_amdgcn_s_barrier()
#define PG8_SCHED __builtin_amdgcn_sched_barrier(0)
    Unit cur, nxt; int ui = 0;
    if (!S.next(0, cur)) return;
    f32x4 acc[2][2][4][2];
#pragma unroll
    for (int a = 0; a < 2; ++a)
#pragma unroll
        for (int b = 0; b < 2; ++b)
#pragma unroll
            for (int m = 0; m < 4; ++m)
#pragma unroll
                for (int n = 0; n < 2; ++n) acc[a][b][m][n] = (f32x4){0.f, 0.f, 0.f, 0.f};
    bf16x8 At[4][2], B0[2][2], B1[2][2];
    const char* cA = (const char*)g.A + (size_t)cur.pm * tstep + (size_t)cur.k0 * kstep; const char* cB = (const char*)g.Bt + (size_t)cur.pn * tstep + (size_t)cur.k0 * kstep;
    S.a_ready(cur);
    if constexpr (SP2) {
        PG8_STAGE(PG8_SB(0, 0), cB, voffB); PG8_STAGE(PG8_SB(0, 1), cB + hstep, voffB); PG8_STAGE(PG8_SA(0, 0), cA, voffA); PG8_STAGE(PG8_SA(0, 1), cA + hstep, voffA);
        if (wr == 1) PG8_BAR;
        PG8_WAIT_V(2); PG8_BAR;
        PG8_STAGE(PG8_SB(1, 0), cB + kstep, voffB); PG8_STAGE(PG8_SA(1, 0), cA + kstep, voffA); PG8_STAGE(PG8_SB(1, 1), cB + hstep + kstep, voffB);
        PG8_WAIT_V(6); PG8_BAR;
    } else {
        PG8_STAGE(PG8_SB(0, 0), cB, voffB); PG8_STAGE(PG8_SA(0, 0), cA, voffA); PG8_STAGE(PG8_SB(0, 1), cB + hstep, voffB); PG8_STAGE(PG8_SA(0, 1), cA + hstep, voffA);
        if (wr == 1) PG8_BAR;
        PG8_WAIT_V(4); PG8_BAR;
        PG8_STAGE(PG8_SB(1, 0), cB + kstep, voffB); PG8_STAGE(PG8_SA(1, 0), cA + kstep, voffA); PG8_STAGE(PG8_SB(1, 1), cB + hstep + kstep, voffB);
        PG8_WAIT_V(6); PG8_BAR;
    }
    for (;;) {
        const bool has_next = S.next(ui + 1, nxt); const int nt = cur.nt;
        const char* nA = has_next ? (const char*)g.A + (size_t)nxt.pm * tstep + (size_t)nxt.k0 * kstep : cA; const char* nB = has_next ? (const char*)g.Bt + (size_t)nxt.pn * tstep + (size_t)nxt.k0 * kstep : cB;
        for (int t = 0; t < nt; t += 2) {
            const bool last = (t == nt - 2);
            const char* a1 = cA + (size_t)(t + 1) * kstep;
            const char* a2 = last ? nA : cA + (size_t)(t + 2) * kstep; const char* b2 = last ? nB : cB + (size_t)(t + 2) * kstep;
            const char* a3 = a2 + kstep; const char* b3 = b2 + kstep;
            if (last && has_next) S.a_ready(nxt);
            if constexpr (SP2) {
            PG8_LDB(B0, 0, 0); PG8_LDB(B1, 0, 1); PG8_SCHED; PG8_LDA(At, 0, 0); PG8_STAGE(PG8_SA(1, 1), a1 + hstep, voffA);
            PG8_WAIT_V(8); PG8_WAIT_L(0); PG8_BAR; PG8_MMA(0, 0, At, B0); PG8_MMA(0, 1, At, B1); PG8_BAR; PG8_SCHED;
            PG8_LDA(At, 0, 1); PG8_STAGE(PG8_SB(0, 0), b2, voffB); PG8_STAGE(PG8_SB(0, 1), b2 + hstep, voffB); PG8_STAGE(PG8_SA(0, 0), a2, voffA);
            PG8_WAIT_V(8); PG8_WAIT_L(0); PG8_BAR; PG8_MMA(1, 0, At, B0); PG8_MMA(1, 1, At, B1); PG8_BAR; PG8_SCHED;
            PG8_LDB(B0, 1, 0); PG8_LDB(B1, 1, 1); PG8_SCHED; PG8_LDA(At, 1, 0); PG8_STAGE(PG8_SA(0, 1), a2 + hstep, voffA);
            PG8_WAIT_V(8); PG8_WAIT_L(0); PG8_BAR; PG8_MMA(0, 0, At, B0); PG8_MMA(0, 1, At, B1); PG8_BAR; PG8_SCHED;
            PG8_LDA(At, 1, 1); PG8_STAGE(PG8_SB(1, 0), b3, voffB); PG8_STAGE(PG8_SB(1, 1), b3 + hstep, voffB); PG8_STAGE(PG8_SA(1, 0), a3, voffA);
            PG8_WAIT_V(8); PG8_WAIT_L(0); PG8_BAR; PG8_MMA(1, 0, At, B0); PG8_MMA(1, 1, At, B1); PG8_BAR; PG8_SCHED;
            } else {
            PG8_LDB(B0, 0, 0); PG8_SCHED; PG8_LDA(At, 0, 0); PG8_STAGE(PG8_SA(1, 1), a1 + hstep, voffA);
            PG8_WAIT_L(8); PG8_BAR; PG8_WAIT_L(0); PG8_MMA(0, 0, At, B0); PG8_BAR; PG8_SCHED;
            PG8_LDB(B1, 0, 1); PG8_STAGE(PG8_SB(0, 0), b2, voffB);
            PG8_BAR; PG8_WAIT_L(0); PG8_MMA(0, 1, At, B1); PG8_BAR;
            PG8_LDA(At, 0, 1); PG8_STAGE(PG8_SA(0, 0), a2, voffA);
            PG8_BAR; PG8_WAIT_L(0); PG8_MMA(1, 0, At, B0); PG8_BAR; PG8_SCHED;
            PG8_STAGE(PG8_SB(0, 1), b2 + hstep, voffB);
            PG8_WAIT_V(6); PG8_BAR; PG8_MMA(1, 1, At, B1); PG8_BAR;
            PG8_LDB(B0, 1, 0); PG8_SCHED; PG8_LDA(At, 1, 0); PG8_STAGE(PG8_SA(0, 1), a2 + hstep, voffA);
            PG8_WAIT_L(8); PG8_BAR; PG8_WAIT_L(0); PG8_MMA(0, 0, At, B0); PG8_BAR; PG8_SCHED;
            PG8_LDB(B1, 1, 1); PG8_STAGE(PG8_SB(1, 0), b3, voffB);
            PG8_BAR; PG8_WAIT_L(0); PG8_MMA(0, 1, At, B1); PG8_BAR;
            PG8_LDA(At, 1, 1); PG8_STAGE(PG8_SA(1, 0), a3, voffA);
            PG8_BAR; PG8_WAIT_L(0); PG8_MMA(1, 0, At, B0); PG8_BAR; PG8_SCHED;
            PG8_STAGE(PG8_SB(1, 1), b3 + hstep, voffB);
            PG8_WAIT_V(6); PG8_BAR; PG8_MMA(1, 1, At, B1); PG8_BAR;
            }
        }
        if constexpr (ALIGN_EPI) { if (wr == 0) PG8_BAR; }
        if constexpr (!Epi::AFTER_DRAIN) { E(acc, cur, wr, wc, fr, fq); S.done(cur); }
        if (!has_next) break;
#pragma unroll
        for (int a = 0; a < 2; ++a)
#pragma unroll
            for (int b = 0; b < 2; ++b)
#pragma unroll
                for (int m = 0; m < 4; ++m)
#pragma unroll
                    for (int n = 0; n < 2; ++n) acc[a][b][m][n] = (f32x4){0.f, 0.f, 0.f, 0.f};
        cur = nxt; cA = nA; cB = nB; ++ui;
        if constexpr (ALIGN_EPI) { if (wr == 1) PG8_BAR; }
    }
    PG8_WAIT_V(0);
    if constexpr (!ALIGN_EPI) { if (wr == 0) PG8_BAR; }
    PG8_BAR;
    if constexpr (Epi::AFTER_DRAIN) { E.fused(acc, cur, wr, wc, fr, fq, lds, wid, lane); S.done(cur); }
#undef PG8_SA
#undef PG8_SB
#undef PG8_STAGE
#undef PG8_LDA
#undef PG8_LDB
#undef PG8_MMA
#undef PG8_WAIT_V
#undef PG8_WAIT_L
#undef PG8_BAR
#undef PG8_SCHED
}
}

#define LAS __attribute__((address_space(3)))
typedef unsigned short bf16;
typedef unsigned v4u __attribute__((ext_vector_type(4)));
typedef unsigned v2u __attribute__((ext_vector_type(2)));
typedef float f32x4 __attribute__((ext_vector_type(4)));
typedef short bf16x8 __attribute__((ext_vector_type(8)));

constexpr int M = 16896, MP = 16384, D = 1024, DIN = 2048, DFF = 2816, DUP = 5632, DEPTH = 4;
constexpr float EPS = 1e-6f;
constexpr int LDS_BYTES = 147456;
constexpr size_t OUT_POOL_P = (size_t)M * D, OUT_CONV_P = OUT_POOL_P + 245760, OUT_FFN_P = OUT_CONV_P + 32768,
                 OUT_POOL_S = OUT_FFN_P + 360448, OUT_CONV_S = OUT_POOL_S + 245760, OUT_FFN_S = OUT_CONV_S + 32768, OUT_END = OUT_FFN_S + 360448;
constexpr size_t MiB = 1u << 20;
constexpr size_t WS_RS = 65536;
constexpr size_t WS_WIN = 1 * MiB, WS_WOUT = 5 * MiB, WS_WUP = 7 * MiB, WS_WDN = 18 * MiB, WS_PMT = 18 * MiB + 5767168, WS_XB = 24 * MiB;
constexpr size_t WS_Z = 57 * MiB, WS_MIXIN = 123 * MiB, WS_MIX = 156 * MiB, WS_PART = 189 * MiB;
constexpr int NS_OUT = 8, NS_DN = 11;
constexpr size_t WS_ACT = 57 * MiB, WS_HEAD = 222 * MiB, WS_TAIL = 234 * MiB, WS_END = 246 * MiB;
static_assert(WS_PMT + 4 * 16384 * 2 <= WS_XB && WS_ACT + (size_t)M * DFF * 2 <= WS_MIX && WS_HEAD + 264 * 2 * 5632 * 4 <= WS_TAIL && WS_TAIL + 264 * 2 * 5632 * 4 <= WS_END, "ws map");

struct Args { const float* in[20]; float* out; unsigned char* ws; };

#define LDS_WAIT() asm volatile("s_waitcnt lgkmcnt(0)" ::: "memory")
__device__ __forceinline__ unsigned f2bf(float f) { unsigned u = __builtin_bit_cast(unsigned, f); return (u + 0x7fffu + ((u >> 16) & 1u)) >> 16; }
__device__ __forceinline__ unsigned pk2(float lo, float hi) { unsigned r; asm("v_cvt_pk_bf16_f32 %0, %1, %2" : "=v"(r) : "v"(lo), "v"(hi)); return r; }
__device__ __forceinline__ float bflo(unsigned w) { return __uint_as_float(w << 16); }
__device__ __forceinline__ float bfhi(unsigned w) { return __uint_as_float(w & 0xffff0000u); }
__device__ __forceinline__ float wave_sum(float v) {
#pragma unroll
    for (int o = 1; o < 64; o <<= 1) v += __shfl_xor(v, o);
    return v;
}
__device__ __forceinline__ float dot4(f32x4 a) { return (a[0] * a[0] + a[1] * a[1]) + (a[2] * a[2] + a[3] * a[3]); }

__device__ __forceinline__ void transpose_item(const float* W, int K, int N, const float* gain_k0, bf16* WT, int mode, LAS float* scr, int item, int lane) {
    const int nblk = N / 32, kb = item / nblk, nb = item % nblk, k0 = 64 * kb, n0 = 32 * nb;
    { f32x4 v[8]; const int kr = lane >> 3, cc = 4 * (lane & 7);
#pragma unroll
      for (int i = 0; i < 8; ++i) v[i] = *(const f32x4*)(W + (size_t)(k0 + 8 * i + kr) * N + n0 + cc);
#pragma unroll
      for (int i = 0; i < 8; ++i) { const int kk = 8 * i + kr; const float g = gain_k0 ? gain_k0[kk] : 1.0f; LAS float* d = scr + kk * 33 + cc; d[0] = v[i][0] * g; d[1] = v[i][1] * g; d[2] = v[i][2] * g; d[3] = v[i][3] * g; } }
    LDS_WAIT(); asm volatile("" ::: "memory");
    int drow = n0;
    if (mode == 1) drow = n0 < DFF ? 256 * (n0 >> 7) + (n0 & 127) : 256 * ((n0 - DFF) >> 7) + 128 + ((n0 - DFF) & 127);
    const int c = lane & 7;
#pragma unroll
    for (int j = 0; j < 4; ++j) { const int n = (lane >> 3) + 8 * j; const LAS float* s = scr + (8 * c) * 33 + n;
        v4u o; o.x = pk2(s[0 * 33], s[1 * 33]); o.y = pk2(s[2 * 33], s[3 * 33]); o.z = pk2(s[4 * 33], s[5 * 33]); o.w = pk2(s[6 * 33], s[7 * 33]);
        *(v4u*)(WT + (size_t)(drow + n) * K + k0 + 8 * c) = o; }
    LDS_WAIT(); asm volatile("" ::: "memory");
}

__device__ __forceinline__ void convert_weights(const Args& a, int l, LAS float* scr, int gw, int NGW, int lane_) {
    const int lane = pg8::lane_id_asm(); (void)lane_;
    constexpr int I_IN = 16 * 64, I_OUT = 16 * 32, I_UP = 16 * 176, I_DN = 44 * 32, I_PM = 4 * 8, NITEMS = I_IN + I_OUT + I_UP + I_DN + I_PM;
    bf16* WIN = (bf16*)(a.ws + WS_WIN); bf16* WOUT = (bf16*)(a.ws + WS_WOUT); bf16* WUP = (bf16*)(a.ws + WS_WUP); bf16* WDN = (bf16*)(a.ws + WS_WDN); bf16* PMT = (bf16*)(a.ws + WS_PMT);
    for (int it = gw; it < NITEMS; it += NGW) {
        int r = it;
        if (r < I_IN) { const int k0 = 64 * (r / 64); transpose_item(a.in[5] + (size_t)l * D * DIN, D, DIN, a.in[12] + l * D + k0, WIN, 0, scr, r, lane); continue; } r -= I_IN;
        if (r < I_OUT) { const int k0 = 64 * (r / 32); const float* gn = k0 < 512 ? a.in[9] + l * 512 + k0 : a.in[10] + l * 512 + (k0 - 512);
            transpose_item(a.in[11] + (size_t)l * D * D, D, D, gn, WOUT, 0, scr, r, lane); continue; } r -= I_OUT;
        if (r < I_UP) { const int k0 = 64 * (r / 176); transpose_item(a.in[16] + (size_t)l * D * DUP, D, DUP, a.in[14] + l * D + k0, WUP, 1, scr, r, lane); continue; } r -= I_UP;
        if (r < I_DN) { transpose_item(a.in[18] + (size_t)l * DFF * D, DFF, D, nullptr, WDN, 0, scr, r, lane); continue; } r -= I_DN;
        const int g = r >> 3; transpose_item(a.in[6] + (size_t)(l * 4 + g) * 16384, 128, 128, nullptr, PMT + (size_t)g * 16384, 0, scr, r & 7, lane);
    }
}

__device__ __forceinline__ void x_prologue(const Args& a, int gw, int NGW, int lane_) {
    const int lane = pg8::lane_id_asm(); (void)lane_;
    bf16* XB = (bf16*)(a.ws + WS_XB); float* RS = (float*)(a.ws + WS_RS);
    for (int mb = gw; mb < M; mb += 2 * NGW) {
        f32x4 x[2][4];
#pragma unroll
        for (int r = 0; r < 2; ++r) { const int m = mb + r * NGW;
            if (m < M) { const float* src = m < MP ? a.in[0] + (size_t)m * D : a.in[1] + (size_t)(m - MP) * D;
#pragma unroll
                for (int j = 0; j < 2; ++j) { x[r][2 * j] = *(const f32x4*)(src + 8 * lane + 512 * j); x[r][2 * j + 1] = *(const f32x4*)(src + 8 * lane + 512 * j + 4); } } }
#pragma unroll
        for (int r = 0; r < 2; ++r) { const int m = mb + r * NGW;
            if (m < M) { float ss = 0.f;
#pragma unroll
                for (int j = 0; j < 4; ++j) ss += dot4(x[r][j]);
                const float rs = rsqrtf(wave_sum(ss) * (1.0f / D) + EPS);
                if (lane == 0) RS[m] = rs;
#pragma unroll
                for (int j = 0; j < 2; ++j) { v4u o; o.x = pk2(x[r][2 * j][0], x[r][2 * j][1]); o.y = pk2(x[r][2 * j][2], x[r][2 * j][3]); o.z = pk2(x[r][2 * j + 1][0], x[r][2 * j + 1][1]); o.w = pk2(x[r][2 * j + 1][2], x[r][2 * j + 1][3]);
                    *(v4u*)(XB + (size_t)m * D + 8 * lane + 512 * j) = o; } } }
    }
}

__device__ __forceinline__ void unpack8(v4u q, float (&f)[8]) { f[0] = bflo(q.x); f[1] = bfhi(q.x); f[2] = bflo(q.y); f[3] = bfhi(q.y); f[4] = bflo(q.z); f[5] = bfhi(q.z); f[6] = bflo(q.w); f[7] = bfhi(q.w); }

__device__ __forceinline__ void add8(float (&s)[8], v4u q) { s[0] += bflo(q.x); s[1] += bfhi(q.x); s[2] += bflo(q.y); s[3] += bfhi(q.y); s[4] += bflo(q.z); s[5] += bfhi(q.z); s[6] += bflo(q.w); s[7] += bfhi(q.w); }
__device__ __forceinline__ void sub8(float (&s)[8], v4u q) { s[0] -= bflo(q.x); s[1] -= bfhi(q.x); s[2] -= bflo(q.y); s[3] -= bfhi(q.y); s[4] -= bflo(q.z); s[5] -= bfhi(q.z); s[6] -= bflo(q.w); s[7] -= bfhi(q.w); }
__device__ __forceinline__ v4u pack_pool(const float (&s)[8], float inv, v4u qc) {
    v4u p; p.x = pk2(s[0] * inv - bflo(qc.x), s[1] * inv - bfhi(qc.x)); p.y = pk2(s[2] * inv - bflo(qc.y), s[3] * inv - bfhi(qc.y));
    p.z = pk2(s[4] * inv - bflo(qc.z), s[5] * inv - bfhi(qc.z)); p.w = pk2(s[6] * inv - bflo(qc.w), s[7] * inv - bfhi(qc.w)); return p; }
template <int W>
__device__ __forceinline__ void pool_rows(const bf16* Z, int seqrow0, int tb, int cg, bool sample, v4u (&pool)[4], v4u (&cur)[4]) {
    constexpr int R = W + 3;
    v4u q[R];
#pragma unroll
    for (int r = 0; r < R; ++r) { const int tr = tb - (W - 1) + r; q[r] = *(const v4u*)(Z + (size_t)(seqrow0 + (tr >= 0 ? tr : 0)) * DIN + cg); if (tr < 0) q[r] = (v4u){0u, 0u, 0u, 0u}; }
    float s[8];
#pragma unroll
    for (int i = 0; i < 8; ++i) s[i] = 0.f;
#pragma unroll
    for (int r = 0; r < W; ++r) add8(s, q[r]);
#pragma unroll
    for (int i = 0; i < 4; ++i) {
        if (i > 0) { add8(s, q[W - 1 + i]); sub8(s, q[i - 1]); }
        const int t = tb + i; const int cnt = sample ? W : (t + 1 < W ? t + 1 : W);
        cur[i] = q[W - 1 + i]; pool[i] = pack_pool(s, 1.0f / (float)cnt, cur[i]);
    }
}
__device__ __forceinline__ void pool_rows_state(const bf16* Z, const float* sp, int seqrow0, int tb, int cg, int W, v4u (&pool)[4], v4u (&cur)[4]) {
#pragma unroll
    for (int i = 0; i < 4; ++i) {
        const int t = tb + i; float s[8];
#pragma unroll
        for (int k = 0; k < 8; ++k) s[k] = 0.f;
        for (int j = 0; j < W; ++j) { const int tr = t - j;
            if (tr >= 0) add8(s, *(const v4u*)(Z + (size_t)(seqrow0 + tr) * DIN + cg));
            else { const float* p = sp + (size_t)(15 + tr) * 512 + cg; const f32x4 a0 = *(const f32x4*)p, a1 = *(const f32x4*)(p + 4);
                s[0] += a0[0]; s[1] += a0[1]; s[2] += a0[2]; s[3] += a0[3]; s[4] += a1[0]; s[5] += a1[1]; s[6] += a1[2]; s[7] += a1[3]; } }
        cur[i] = *(const v4u*)(Z + (size_t)(seqrow0 + t) * DIN + cg); pool[i] = pack_pool(s, 1.0f / (float)W, cur[i]);
    }
}

__device__ __forceinline__ void mixer_phase(const Args& a, int l, int it0, int itn, int its, int lane_, LAS unsigned char* wlds  ) {
    const int lane = pg8::lane_id_asm(); (void)lane_;
    const bf16* Z = (const bf16*)(a.ws + WS_Z); bf16* MIXIN = (bf16*)(a.ws + WS_MIXIN); const bf16* PMT = (const bf16*)(a.ws + WS_PMT);
    const float* state_pool = a.in[2]; const float* state_conv = a.in[3];
    const float* pool_scale = a.in[7] + l * 512; const float* conv_w = a.in[8] + l * 3 * 512;
    const int fr = lane & 15, fq = lane >> 4;
    for (int it = it0; it < itn; it += its) {
        const int tb = it / 5, task = it - tb * 5;
        const int m0 = tb * 16; const bool sample = m0 >= MP;
        int seq, t0, T; if (!sample) { seq = m0 >> 11; t0 = m0 & 2047; T = 2048; } else { seq = (m0 - MP) >> 6; t0 = (m0 - MP) & 63; T = 64; }
        const int seqrow0 = m0 - t0;
        if (task < 4) {
            const int g = task;
            const bool last = (t0 + 16 == T);
            float* out_pool = a.out + (sample ? OUT_POOL_S : OUT_POOL_P) + (size_t)(l * 8 + seq) * 15 * 512;
            { const int cg = g * 128 + 8 * fr, tbq = t0 + 4 * fq;
              v4u pool[4], cur[4];
              if (sample && t0 == 0) pool_rows_state(Z, state_pool + (size_t)(l * 8 + seq) * 15 * 512, seqrow0, tbq, cg, 2 << g, pool, cur);
              else if (g == 0) pool_rows<2>(Z, seqrow0, tbq, cg, sample, pool, cur);
              else if (g == 1) pool_rows<4>(Z, seqrow0, tbq, cg, sample, pool, cur);
              else if (g == 2) pool_rows<8>(Z, seqrow0, tbq, cg, sample, pool, cur);
              else pool_rows<16>(Z, seqrow0, tbq, cg, sample, pool, cur);
#pragma unroll
              for (int i = 0; i < 4; ++i) {
                  *(LAS v4u*)(wlds + (4 * fq + i) * 272 + 16 * fr) = pool[i];
                  const int ti = 4 * fq + i;
                  if (last && ti >= 1) { float* op = out_pool + (size_t)(ti - 1) * 512 + cg;
                      *(f32x4*)op = (f32x4){bflo(cur[i].x), bfhi(cur[i].x), bflo(cur[i].y), bfhi(cur[i].y)}; *(f32x4*)(op + 4) = (f32x4){bflo(cur[i].z), bfhi(cur[i].z), bflo(cur[i].w), bfhi(cur[i].w)}; }
              } }
            LDS_WAIT(); asm volatile("" ::: "memory");
            bf16x8 pf[4];
#pragma unroll
            for (int ks = 0; ks < 4; ++ks) pf[ks] = *(const LAS bf16x8*)(wlds + fr * 272 + ks * 64 + fq * 16);
            f32x4 ya[8]; float ss = 0.f;
#pragma unroll
            for (int n = 0; n < 8; ++n) {
                f32x4 acc = {0.f, 0.f, 0.f, 0.f};
                const int drow = 32 * (n >> 1) + 8 * (fr >> 2) + 4 * (n & 1) + (fr & 3);
#pragma unroll
                for (int ks = 0; ks < 4; ++ks) {
                    const bf16x8 wf = *(const bf16x8*)(PMT + (size_t)g * 16384 + (size_t)drow * 128 + ks * 32 + fq * 8);
                    acc = __builtin_amdgcn_mfma_f32_16x16x32_bf16(wf, pf[ks], acc, 0, 0, 0);
                }
                const f32x4 sc = *(const f32x4*)(pool_scale + g * 128 + 32 * (n >> 1) + 8 * fq + 4 * (n & 1));
                acc = acc * sc; ya[n] = acc; ss += dot4(acc);
            }
            ss += __shfl_xor(ss, 16); ss += __shfl_xor(ss, 32);
            const float rs = rsqrtf(ss * (1.0f / 128.0f) + EPS);
#pragma unroll
            for (int np = 0; np < 4; ++np) { v4u o; o.x = pk2(ya[2 * np][0] * rs, ya[2 * np][1] * rs); o.y = pk2(ya[2 * np][2] * rs, ya[2 * np][3] * rs); o.z = pk2(ya[2 * np + 1][0] * rs, ya[2 * np + 1][1] * rs); o.w = pk2(ya[2 * np + 1][2] * rs, ya[2 * np + 1][3] * rs);
                *(v4u*)(MIXIN + (size_t)(m0 + fr) * D + g * 128 + 32 * np + 8 * fq) = o; }
            LDS_WAIT(); asm volatile("" ::: "memory");
        } else {
            const int c0 = lane * 8;
            float* out_conv = a.out + (sample ? OUT_CONV_S : OUT_CONV_P) + (size_t)(l * 8 + seq) * 2 * 512;
            float w0[8], w1[8], w2[8], cm2[8], cm1[8];
            { const f32x4 q0 = *(const f32x4*)(conv_w + c0), q1 = *(const f32x4*)(conv_w + c0 + 4); w0[0] = q0[0]; w0[1] = q0[1]; w0[2] = q0[2]; w0[3] = q0[3]; w0[4] = q1[0]; w0[5] = q1[1]; w0[6] = q1[2]; w0[7] = q1[3]; }
            { const f32x4 q0 = *(const f32x4*)(conv_w + 512 + c0), q1 = *(const f32x4*)(conv_w + 512 + c0 + 4); w1[0] = q0[0]; w1[1] = q0[1]; w1[2] = q0[2]; w1[3] = q0[3]; w1[4] = q1[0]; w1[5] = q1[1]; w1[6] = q1[2]; w1[7] = q1[3]; }
            { const f32x4 q0 = *(const f32x4*)(conv_w + 1024 + c0), q1 = *(const f32x4*)(conv_w + 1024 + c0 + 4); w2[0] = q0[0]; w2[1] = q0[1]; w2[2] = q0[2]; w2[3] = q0[3]; w2[4] = q1[0]; w2[5] = q1[1]; w2[6] = q1[2]; w2[7] = q1[3]; }
            if (t0 > 0) {
                float gc[8], u[8];
                unpack8(*(const v4u*)(Z + (size_t)(m0 - 2) * DIN + 1024 + c0), gc); unpack8(*(const v4u*)(Z + (size_t)(m0 - 2) * DIN + 1536 + c0), u);
#pragma unroll
                for (int i = 0; i < 8; ++i) cm2[i] = gc[i] * u[i];
                unpack8(*(const v4u*)(Z + (size_t)(m0 - 1) * DIN + 1024 + c0), gc); unpack8(*(const v4u*)(Z + (size_t)(m0 - 1) * DIN + 1536 + c0), u);
#pragma unroll
                for (int i = 0; i < 8; ++i) cm1[i] = gc[i] * u[i];
            } else if (sample) {
                const float* sp = state_conv + (size_t)(l * 8 + seq) * 2 * 512 + c0;
                const f32x4 a0 = *(const f32x4*)sp, a1 = *(const f32x4*)(sp + 4), b0 = *(const f32x4*)(sp + 512), b1 = *(const f32x4*)(sp + 516);
                cm2[0] = a0[0]; cm2[1] = a0[1]; cm2[2] = a0[2]; cm2[3] = a0[3]; cm2[4] = a1[0]; cm2[5] = a1[1]; cm2[6] = a1[2]; cm2[7] = a1[3];
                cm1[0] = b0[0]; cm1[1] = b0[1]; cm1[2] = b0[2]; cm1[3] = b0[3]; cm1[4] = b1[0]; cm1[5] = b1[1]; cm1[6] = b1[2]; cm1[7] = b1[3];
            } else {
#pragma unroll
                for (int i = 0; i < 8; ++i) { cm2[i] = 0.f; cm1[i] = 0.f; }
            }
#pragma unroll 1
            for (int ib = 0; ib < 16; ib += 8) {
                v4u qb[8], qc[8], qu[8];
#pragma unroll
                for (int ii = 0; ii < 8; ++ii) { const size_t row = (size_t)(m0 + ib + ii); qb[ii] = *(const v4u*)(Z + row * DIN + 512 + c0); qc[ii] = *(const v4u*)(Z + row * DIN + 1024 + c0); qu[ii] = *(const v4u*)(Z + row * DIN + 1536 + c0); }
#pragma unroll
                for (int ii = 0; ii < 8; ++ii) {
                    const int i = ib + ii, t = t0 + i; const size_t row = (size_t)(m0 + i);
                    float gb[8], gc[8], u[8], cu[8], yb[8];
                    unpack8(qb[ii], gb); unpack8(qc[ii], gc); unpack8(qu[ii], u);
                    float ss = 0.f;
#pragma unroll
                    for (int k = 0; k < 8; ++k) { cu[k] = gc[k] * u[k]; const float co = w0[k] * cm2[k] + w1[k] * cm1[k] + w2[k] * cu[k]; yb[k] = gb[k] * co; ss += yb[k] * yb[k]; }
                    ss += __shfl_xor(ss, 1); ss += __shfl_xor(ss, 2); ss += __shfl_xor(ss, 4);
                    const float rs = rsqrtf(ss * (1.0f / 64.0f) + EPS);
                    v4u o; o.x = pk2(yb[0] * rs, yb[1] * rs); o.y = pk2(yb[2] * rs, yb[3] * rs); o.z = pk2(yb[4] * rs, yb[5] * rs); o.w = pk2(yb[6] * rs, yb[7] * rs);
                    *(v4u*)(MIXIN + row * D + 512 + c0) = o;
                    if (t >= T - 2) { float* op = out_conv + (size_t)(t - (T - 2)) * 512 + c0; *(f32x4*)op = (f32x4){cu[0], cu[1], cu[2], cu[3]}; *(f32x4*)(op + 4) = (f32x4){cu[4], cu[5], cu[6], cu[7]}; }
#pragma unroll
                    for (int k = 0; k < 8; ++k) { cm2[k] = cm1[k]; cm1[k] = cu[k]; }
                }
            }
        }
    }
}

__device__ __forceinline__ void xupd_phase(const Args& a, const float* gpost, int nparts, bool final_, int gw, int NGW, int lane_, int m_lo = 0) {
    const int lane = pg8::lane_id_asm(); (void)lane_;
    const bf16* P = (const bf16*)(a.ws + WS_MIX); const float* PART = (const float*)(a.ws + WS_PART); bf16* XB = (bf16*)(a.ws + WS_XB); float* RS = (float*)(a.ws + WS_RS); const float* gfin = a.in[19];
    for (int mb = m_lo + gw; mb < M; mb += 2 * NGW) {
        float x[2][16], mx[2][16]; float ss[2] = {0.f, 0.f};
#pragma unroll
        for (int r = 0; r < 2; ++r) {
            const int m = mb + r * NGW;
            if (m < M) {
#pragma unroll
                for (int j = 0; j < 2; ++j) { float f[8]; unpack8(*(const v4u*)(XB + (size_t)m * D + 8 * lane + 512 * j), f);
#pragma unroll
                    for (int i = 0; i < 8; ++i) x[r][8 * j + i] = f[i]; }
                if (m < MP) {
#pragma unroll
                    for (int j = 0; j < 2; ++j) { float f[8]; unpack8(*(const v4u*)(P + (size_t)m * D + 8 * lane + 512 * j), f);
#pragma unroll
                        for (int i = 0; i < 8; ++i) mx[r][8 * j + i] = f[i]; }
                } else {
#pragma unroll
                    for (int i = 0; i < 16; ++i) mx[r][i] = 0.f;
                    for (int k = 0; k < nparts; ++k) {
#pragma unroll
                        for (int j = 0; j < 2; ++j) { const float* pp = PART + ((size_t)k * 512 + (m - MP)) * D + 8 * lane + 512 * j; const f32x4 p0 = *(const f32x4*)pp, p1 = *(const f32x4*)(pp + 4);
                            mx[r][8 * j + 0] += p0[0]; mx[r][8 * j + 1] += p0[1]; mx[r][8 * j + 2] += p0[2]; mx[r][8 * j + 3] += p0[3]; mx[r][8 * j + 4] += p1[0]; mx[r][8 * j + 5] += p1[1]; mx[r][8 * j + 6] += p1[2]; mx[r][8 * j + 7] += p1[3]; }
                    }
                }
#pragma unroll
                for (int i = 0; i < 16; ++i) ss[r] += mx[r][i] * mx[r][i];
            }
        }
#pragma unroll
        for (int r = 0; r < 2; ++r) {
            const int m = mb + r * NGW;
            if (m < M) {
                const float rs = rsqrtf(wave_sum(ss[r]) * (1.0f / D) + EPS);
                float ss2 = 0.f;
#pragma unroll
                for (int j = 0; j < 2; ++j) { const float* gp = gpost + 8 * lane + 512 * j; const f32x4 g0 = *(const f32x4*)gp, g1 = *(const f32x4*)(gp + 4);
#pragma unroll
                    for (int i = 0; i < 4; ++i) { x[r][8 * j + i] += mx[r][8 * j + i] * rs * g0[i]; x[r][8 * j + 4 + i] += mx[r][8 * j + 4 + i] * rs * g1[i]; } }
#pragma unroll
                for (int i = 0; i < 16; ++i) ss2 += x[r][i] * x[r][i];
                const float rs2 = rsqrtf(wave_sum(ss2) * (1.0f / D) + EPS);
                if (final_) {
#pragma unroll
                    for (int j = 0; j < 2; ++j) { const float* gp = gfin + 8 * lane + 512 * j; const f32x4 g0 = *(const f32x4*)gp, g1 = *(const f32x4*)(gp + 4); float* yo = a.out + (size_t)m * D + 8 * lane + 512 * j;
                        *(f32x4*)yo = (f32x4){x[r][8 * j + 0] * rs2 * g0[0], x[r][8 * j + 1] * rs2 * g0[1], x[r][8 * j + 2] * rs2 * g0[2], x[r][8 * j + 3] * rs2 * g0[3]};
                        *(f32x4*)(yo + 4) = (f32x4){x[r][8 * j + 4] * rs2 * g1[0], x[r][8 * j + 5] * rs2 * g1[1], x[r][8 * j + 6] * rs2 * g1[2], x[r][8 * j + 7] * rs2 * g1[3]}; }
                } else {
#pragma unroll
                    for (int j = 0; j < 2; ++j) { v4u o; o.x = pk2(x[r][8 * j + 0], x[r][8 * j + 1]); o.y = pk2(x[r][8 * j + 2], x[r][8 * j + 3]); o.z = pk2(x[r][8 * j + 4], x[r][8 * j + 5]); o.w = pk2(x[r][8 * j + 6], x[r][8 * j + 7]);
                        *(v4u*)(XB + (size_t)m * D + 8 * lane + 512 * j) = o; }
                    if (lane == 0) RS[m] = rs2;
                }
            }
        }
    }
}

__device__ __forceinline__ void fixup_block(const Args& a, int l, int blk, int c4) {
    const float* HEAD = (const float*)(a.ws + WS_HEAD); const float* TAIL = (const float*)(a.ws + WS_TAIL); bf16* ACT = (bf16*)(a.ws + WS_ACT);
    const float* cw = a.in[17] + (size_t)l * 3 * DUP; const float* state_ffn = a.in[4];
    const int pg = 256 * (c4 >> 7) + (c4 & 127), pv = pg + 128;
    const bool sample = blk >= 256, seqstart = sample || (blk & 31) == 0;
    f32x4 g2 = {0.f, 0.f, 0.f, 0.f}, g1 = g2, v2 = g2, v1 = g2;
    if (!seqstart) { const float* tp = TAIL + (size_t)(blk - 1) * 2 * DUP; g2 = *(const f32x4*)(tp + pg); g1 = *(const f32x4*)(tp + DUP + pg); v2 = *(const f32x4*)(tp + pv); v1 = *(const f32x4*)(tp + DUP + pv); }
    else if (sample) { const float* sp = state_ffn + (size_t)(l * 8 + (blk - 256)) * 2 * DUP; g2 = *(const f32x4*)(sp + c4); g1 = *(const f32x4*)(sp + DUP + c4); v2 = *(const f32x4*)(sp + DFF + c4); v1 = *(const f32x4*)(sp + DUP + DFF + c4); }
    const float* hp = HEAD + (size_t)blk * 2 * DUP;
    const f32x4 h0g = *(const f32x4*)(hp + pg), h1g = *(const f32x4*)(hp + DUP + pg), h0v = *(const f32x4*)(hp + pv), h1v = *(const f32x4*)(hp + DUP + pv);
    const f32x4 w0g = *(const f32x4*)(cw + c4), w1g = *(const f32x4*)(cw + DUP + c4), w2g = *(const f32x4*)(cw + 2 * DUP + c4);
    const f32x4 w0v = *(const f32x4*)(cw + DFF + c4), w1v = *(const f32x4*)(cw + DUP + DFF + c4), w2v = *(const f32x4*)(cw + 2 * DUP + DFF + c4);
    const f32x4 cg0 = w0g * g2 + w1g * g1 + w2g * h0g, cv0 = w0v * v2 + w1v * v1 + w2v * h0v;
    const f32x4 cg1 = w0g * g1 + w1g * h0g + w2g * h1g, cv1 = w0v * v1 + w1v * h0v + w2v * h1v;
    v2u o0, o1;
    o0.x = pk2(pg8::silu_f(cg0[0]) * cv0[0], pg8::silu_f(cg0[1]) * cv0[1]); o0.y = pk2(pg8::silu_f(cg0[2]) * cv0[2], pg8::silu_f(cg0[3]) * cv0[3]);
    o1.x = pk2(pg8::silu_f(cg1[0]) * cv1[0], pg8::silu_f(cg1[1]) * cv1[1]); o1.y = pk2(pg8::silu_f(cg1[2]) * cv1[2], pg8::silu_f(cg1[3]) * cv1[3]);
    *(v2u*)(ACT + (size_t)(64 * blk) * DFF + c4) = o0; *(v2u*)(ACT + (size_t)(64 * blk + 1) * DFF + c4) = o1;
}
template <class Sched>
__device__ __forceinline__ void fixup_for_units(const Args& a, int l, const Sched& S, int tid_, int gtid_, int NT) {
    const int tid = tid_ * 64 + pg8::lane_id_asm(), gtid = gtid_ * 512 + tid;
    pg8::Unit u; int prev = -1;
    for (int i = 0; S.next(i, u); ++i) {
        if (u.pm == prev) continue;
        prev = u.pm;
        for (int it = tid; it < 4 * 704; it += 512) { const int b = it / 704; fixup_block(a, l, 4 * u.pm + b, (it - b * 704) * 4); }
    }
    const float* TAIL = (const float*)(a.ws + WS_TAIL);
    for (int it = gtid; it < 16 * 2 * 1408; it += NT) {
        const int sq = it / 2816, r = it - sq * 2816, i = r / 1408, c4 = (r - i * 1408) * 4;
        const int blk = sq < 8 ? 32 * sq + 31 : 256 + (sq - 8);
        const int pc = c4 < DFF ? 256 * (c4 >> 7) + (c4 & 127) : 256 * ((c4 - DFF) >> 7) + 128 + ((c4 - DFF) & 127);
        const f32x4 v = *(const f32x4*)(TAIL + ((size_t)blk * 2 + i) * DUP + pc);
        *(f32x4*)(a.out + (sq < 8 ? OUT_FFN_P : OUT_FFN_S) + ((size_t)(l * 8 + (sq & 7)) * 2 + i) * DUP + c4) = v;
    }
    asm volatile("s_waitcnt vmcnt(0)" ::: "memory");
    __syncthreads();
    __builtin_amdgcn_fence(__ATOMIC_ACQUIRE, "agent");
}

#define XB_TMO      128
#define XB_XCNT(j)  (256  + 64 * (j))
#define XB_XSUB(j)  (1280 + 64 * (j))
#define XB_XGEN(j)  (2304 + 64 * (j))
#define XB_TOP      3328
#define XB_TOPGEN   3392
#define XCD_BAR_WORDS 3456
#define XB_SPIN_CAP (1u << 18)

__device__ __forceinline__ unsigned xb_ld(unsigned* p)              { return __hip_atomic_load(p, __ATOMIC_RELAXED, __HIP_MEMORY_SCOPE_AGENT); }
__device__ __forceinline__ unsigned xb_add(unsigned* p, unsigned v) { return __hip_atomic_fetch_add(p, v, __ATOMIC_RELAXED, __HIP_MEMORY_SCOPE_AGENT); }
__device__ __forceinline__ unsigned xb_xcc_id() { return (unsigned)__builtin_amdgcn_s_getreg((3 << 11) | 20) & 0xFu; }
#define XB_SPIN(cond, bar) do { unsigned _sp = 0; while (cond) { __builtin_amdgcn_s_sleep(1); \
    if ((++_sp & 255u) == 0u) { if (xb_ld(&(bar)[XB_TMO])) break; if (_sp > XB_SPIN_CAP) { atomicAdd(&(bar)[XB_TMO], 1u); break; } } } } while (0)

struct XcdBarrier {
    unsigned* bar; unsigned x; int wave;
    volatile LAS unsigned* st;
};

__device__ __forceinline__ XcdBarrier xcd_barrier_post(unsigned* bar, volatile LAS unsigned* st) {
    XcdBarrier b; b.bar = bar; b.x = xb_xcc_id(); b.st = st;
    if (__builtin_amdgcn_readfirstlane((int)threadIdx.x >> 6) == 0 && pg8::lane_id_asm() == 0) (void)xb_add(&bar[XB_XCNT(b.x)], 1u);
    return b;
}
__device__ __forceinline__ void xcd_barrier_complete(unsigned* bar, unsigned x, unsigned& nloc, unsigned& nx) {
    const unsigned G = gridDim.x * gridDim.y * gridDim.z;
    unsigned sum, cnt, mine, sp = 0u;
    for (;;) {
        sum = 0u; cnt = 0u; mine = 0u;
#pragma unroll
        for (unsigned j = 0; j < 16; ++j) { const unsigned c = xb_ld(&bar[XB_XCNT(j)]); sum += c; cnt += (c > 0u) ? 1u : 0u; mine = (j == x) ? c : mine; }
        if (sum == G) break;
        __builtin_amdgcn_s_sleep(1);
        if ((++sp & 255u) == 0u) { if (xb_ld(&bar[XB_TMO])) break; if (sp > XB_SPIN_CAP) { atomicAdd(&bar[XB_TMO], 1u); break; } }
    }
    nloc = mine > 0u ? mine : 1u; nx = cnt > 0u ? cnt : 1u;
}

__device__ __forceinline__ void xcd_barrier(const XcdBarrier& b) {
    asm volatile("s_waitcnt vmcnt(0)" ::: "memory");
    __syncthreads();
    if (b.wave == 0 && pg8::lane_id_asm() == 0) {
        unsigned* bar = b.bar;
        __builtin_amdgcn_s_waitcnt(0);
        unsigned nloc = b.st[0], nx = b.st[1];
        if (nloc == 0u) { xcd_barrier_complete(bar, b.x, nloc, nx); b.st[0] = nloc; b.st[1] = nx; }
        const unsigned old = xb_add(&bar[XB_XSUB(b.x)], 1u);
        const unsigned gen = old / nloc;
        if (old + 1u == (gen + 1u) * nloc) {
            __builtin_amdgcn_fence(__ATOMIC_RELEASE, "agent");
            asm volatile("s_waitcnt vmcnt(0)" ::: "memory");
            const unsigned og = xb_add(&bar[XB_TOP], 1u);
            const unsigned tg = og / nx;
            if (og + 1u == (tg + 1u) * nx) xb_add(&bar[XB_TOPGEN], 1u);
            else XB_SPIN(xb_ld(&bar[XB_TOPGEN]) == tg, bar);
            __builtin_amdgcn_fence(__ATOMIC_ACQUIRE, "agent");
            xb_add(&bar[XB_XGEN(b.x)], 1u);
            asm volatile("s_waitcnt vmcnt(0)" ::: "memory");
        } else {
            XB_SPIN(xb_ld(&bar[XB_XGEN(b.x)]) == gen, bar);
            __builtin_amdgcn_fence(__ATOMIC_ACQUIRE, "agent");
            asm volatile("s_waitcnt vmcnt(0)" ::: "memory");
        }
    }
    __syncthreads();
}

__device__ __forceinline__ void sub_barrier(unsigned* cnt, unsigned n, int wave) {
    asm volatile("s_waitcnt vmcnt(0)" ::: "memory");
    __syncthreads();
    if (wave == 0 && pg8::lane_id_asm() == 0) {
        __builtin_amdgcn_fence(__ATOMIC_RELEASE, "agent");
        asm volatile("s_waitcnt vmcnt(0)" ::: "memory");
        __hip_atomic_fetch_add(cnt, 1u, __ATOMIC_RELAXED, __HIP_MEMORY_SCOPE_AGENT);
        unsigned spins = 0;
        while (__hip_atomic_load(cnt, __ATOMIC_RELAXED, __HIP_MEMORY_SCOPE_AGENT) < n) { __builtin_amdgcn_s_sleep(2); if (++spins > (1u << 22)) break; }
        __builtin_amdgcn_fence(__ATOMIC_ACQUIRE, "agent");
        asm volatile("s_waitcnt vmcnt(0)" ::: "memory");
    }
    __syncthreads();
}
#define LAYER_BODY(l) do { \
        { \
          { pg8::Gemm g{XB, WIN, D}; pg8::MixedOrder S; S.init(DIN, D / 64, 0, G, bx); pg8::EpiStore E{Z, DIN, nullptr, (const float*)(a.ws + WS_RS)}; \
            pg8::gemm_phase<pg8::EpiStore, pg8::MixedOrder, true, true>(lds, g, S, E, wave); } \
          xcd_barrier(bar); \
          if (bx < 16) {   \
            { pg8::Gemm g{XB, WIN, D}; pg8::SampleOrder S; S.init(DIN, D / 64, bx); pg8::EpiStore E{Z, DIN, nullptr, (const float*)(a.ws + WS_RS)}; \
              pg8::gemm_phase<pg8::EpiStore, pg8::SampleOrder, true, true>(lds, g, S, E, wave); } \
            sub_barrier((unsigned*)a.ws + 3520 + 64 * l, 16u, wave); \
          } \
          mixer_phase(a, l, bx < 16 ? 5120 + bx * 8 + wave : (bx - 16) * 8 + wave, bx < 16 ? 5280 : 5120, bx < 16 ? 128 : 1920, 0, lds + wave * 16384); \
        } \
        xcd_barrier(bar); \
        { pg8::Gemm g{MIXIN, WOUT, D}; pg8::MixedOrder S; S.init(D, D / 64, NS_OUT, G, bx); pg8::EpiStore E{MIX, D, (float*)(a.ws + WS_PART), nullptr}; \
          pg8::gemm_phase<pg8::EpiStore, pg8::MixedOrder, true, true>(lds, g, S, E, wave); } \
        xcd_barrier(bar); \
        xupd_phase(a, a.in[13] + l * D, NS_OUT, false, gw, NGW, 0); \
        xcd_barrier(bar); \
        { pg8::Gemm g{XB, WUP, D}; pg8::MixedOrder S; S.init(DUP, D / 64, 1, G, bx); \
          pg8::EpiUp E{ACT, (float*)(a.ws + WS_HEAD), (float*)(a.ws + WS_TAIL), a.in[17] + (size_t)l * 3 * DUP, (const float*)(a.ws + WS_RS)}; \
          pg8::gemm_phase<pg8::EpiUp, pg8::MixedOrder, true, true>(lds, g, S, E, wave); } \
        xcd_barrier(bar); \
        { pg8::Gemm g{ACT, WDN, DFF}; pg8::MixedOrder S; S.init(D, DFF / 64, NS_DN, G, bx); pg8::EpiStore E{MIX, D, (float*)(a.ws + WS_PART), nullptr}; \
          fixup_for_units(a, l, S, wave, bx, G * 512); \
          pg8::gemm_phase<pg8::EpiStore, pg8::MixedOrder, true, true>(lds, g, S, E, wave); } \
        xcd_barrier(bar); \
        xupd_phase(a, a.in[15] + l * D, NS_DN, l == DEPTH - 1, gw, NGW, 0); \
        if (l + 1 < DEPTH) { convert_weights(a, l + 1, scr, gw, NGW, 0); xcd_barrier(bar); } \
 } while (0)
__global__ void __launch_bounds__(512, 2) fwd_megakernel(Args a) {
    extern __shared__ __attribute__((aligned(16))) unsigned char lds_raw[];
    LAS unsigned char* lds = (LAS unsigned char*)lds_raw;
    cg::grid_group grid = cg::this_grid();
    const int wave = __builtin_amdgcn_readfirstlane((int)threadIdx.x >> 6);
    const int G = gridDim.x, bx = blockIdx.x;
    const int vcu = (G % 8 == 0) ? (bx % 8) * (G / 8) + bx / 8 : bx;
    const int gw = vcu * 8 + wave, NGW = G * 8;
    LAS float* scr = (LAS float*)(lds + wave * 16384);
    bf16* XB = (bf16*)(a.ws + WS_XB); bf16* Z = (bf16*)(a.ws + WS_Z); bf16* MIXIN = (bf16*)(a.ws + WS_MIXIN); bf16* MIX = (bf16*)(a.ws + WS_MIX); bf16* ACT = (bf16*)(a.ws + WS_ACT);
    const bf16* WIN = (const bf16*)(a.ws + WS_WIN); const bf16* WOUT = (const bf16*)(a.ws + WS_WOUT); const bf16* WUP = (const bf16*)(a.ws + WS_WUP); const bf16* WDN = (const bf16*)(a.ws + WS_WDN);

    volatile LAS unsigned* bst = (volatile LAS unsigned*)(lds + 131072);
    if (threadIdx.x < 2) bst[threadIdx.x] = 0u;
    __syncthreads();
    XcdBarrier bar = xcd_barrier_post((unsigned*)a.ws, bst); bar.wave = wave;
    if (a.ws == nullptr) grid.sync();
    convert_weights(a, 0, scr, gw, NGW, 0);
    x_prologue(a, gw, NGW, 0);
    xcd_barrier(bar);
    LAYER_BODY(0); LAYER_BODY(1); LAYER_BODY(2); LAYER_BODY(3);
}

extern "C" void kernel_launch(void* const* d_in, const int* in_sizes, int n_in, void* d_out, int out_size, void* d_ws, size_t ws_size, hipStream_t stream) {
    static int grid = 0;
    if (grid == 0) {
        if (n_in != 20 || (size_t)out_size != OUT_END || ws_size < WS_END) { fprintf(stderr, "kernel_launch: unexpected shapes (n_in %d out %d ws %zu); nothing launched\n", n_in, out_size, ws_size); grid = -1; return; }
        int dev = 0, cus = 0, per_cu = 0;
        (void)hipGetDevice(&dev);
        (void)hipDeviceGetAttribute(&cus, hipDeviceAttributeMultiprocessorCount, dev);
        (void)hipFuncSetAttribute((const void*)fwd_megakernel, hipFuncAttributeMaxDynamicSharedMemorySize, LDS_BYTES);
        (void)hipOccupancyMaxActiveBlocksPerMultiprocessor(&per_cu, (const void*)fwd_megakernel, 512, LDS_BYTES);
        if (per_cu < 1) per_cu = 1;
        grid = cus * per_cu;
        if (grid != 256) { fprintf(stderr, "kernel_launch: this kernel's phase program is laid out for 256 resident workgroups (one per CU of a 256-CU device), got %d; nothing launched\n", grid); grid = -1; return; }
    }
    if (grid < 0) return;
    if (hipMemsetAsync(d_ws, 0, 16384, stream) != hipSuccess) { fprintf(stderr, "kernel_launch: hipMemsetAsync of the barrier words failed\n"); return; }
    Args a{};
    for (int i = 0; i < 20; ++i) a.in[i] = (const float*)d_in[i];
    a.out = (float*)d_out; a.ws = (unsigned char*)d_ws;
    void* args[] = {&a};
    hipError_t e = hipLaunchCooperativeKernel((const void*)fwd_megakernel, dim3(grid), dim3(512), args, LDS_BYTES, stream);
    if (e != hipSuccess) fprintf(stderr, "cooperative launch failed: %s (grid %d)\n", hipGetErrorString(e), grid);
}
```

```cpp
#include <hip/hip_runtime.h>
#include <hip/hip_cooperative_groups.h>
#include <cstdio>
#include <cstdint>
namespace cg = cooperative_groups;

namespace pg8 {
#define PG8_LAS __attribute__((address_space(3)))
typedef unsigned short bf16_t;
typedef short bf16x8 __attribute__((ext_vector_type(8)));
typedef float f32x4 __attribute__((ext_vector_type(4)));
typedef unsigned u32x4 __attribute__((ext_vector_type(4)));
constexpr int BM = 256, BK = 64, HALF = 128, HTB = HALF * BK * 2  , STAGE_BYTES = 8 * HTB, NXCD = 8, WGM = 8;

__host__ __device__ __forceinline__ int lds_byte(int r, int c) { const int st = (r >> 4) * 2 + (c >> 5), rr = r & 15, cc = c & 31, ob = rr * 64 + cc * 2; return st * 1024 + (ob ^ (((ob >> 9) & 1) << 5)); }
__host__ __device__ __forceinline__ void stage_rc(int b, int& R, int& C) { const int st = b / 1024, sb = b % 1024, swz = sb ^ (((sb >> 9) & 1) << 5); R = (st >> 1) * 16 + swz / 64; C = (st & 1) * 32 + (swz % 64) / 2; }
__host__ __device__ __forceinline__ int perm32(int rho) { const int n = rho >> 4, i = rho & 15; return 8 * (i >> 2) + 4 * n + (i & 3); }

__device__ __forceinline__ int lane_id_asm() { int l; asm volatile("v_mbcnt_lo_u32_b32 %0, -1, 0\n\tv_mbcnt_hi_u32_b32 %0, -1, %0" : "=v"(l)); return l; }
struct Unit { int pm, pn, ks, k0, nt; };
struct Gemm { const bf16_t* A; const bf16_t* Bt; int ld; };

struct MixedOrder {
    int nN, nP, nS, ntF, ntS, nwg, G, c;
    __host__ __device__ __forceinline__ void init(int N, int ntFull, int nSplit, int G_, int c_) { nN = N / BM; nP = 64 * nN; nS = nSplit; ntF = ntFull; ntS = nSplit ? ntFull / nSplit : 0; nwg = nP + 2 * nN * nS;   G = G_; c = c_; }
    __host__ __device__ __forceinline__ bool next(int i, Unit& u) const {
        const long L = (long)i * G + c; if (L >= nwg) return false;
        int wgid = (int)L;
        if (wgid < nP) {
            { const int q = nP / NXCD, xcd = wgid % NXCD, off = wgid / NXCD; wgid = xcd * q + off; }
            const int nig = WGM * nN, gid = wgid / nig, fm = gid * WGM;
            u.pm = fm + ((wgid % nig) % WGM); u.pn = (wgid % nig) / WGM; u.ks = 0; u.k0 = 0; u.nt = ntF;
        } else {
            wgid -= nP; u.ks = wgid % nS; const int t = wgid / nS; u.pm = 64 + t / nN; u.pn = t % nN; u.k0 = u.ks * ntS; u.nt = ntS;
        }
        return true;
    }
    __device__ __forceinline__ void a_ready(const Unit&) const {}
    __device__ __forceinline__ void done(const Unit&) const {}
};

struct SampleOrder {
    int nN, ntF, c;
    __host__ __device__ __forceinline__ void init(int N, int ntFull, int c_) { nN = N / BM; ntF = ntFull; c = c_; }
    __host__ __device__ __forceinline__ bool next(int i, Unit& u) const { if (i != 0 || c >= 2 * nN) return false; u.pm = 64 + c / nN; u.pn = c % nN; u.ks = 0; u.k0 = 0; u.nt = ntF; return true; }
    __device__ __forceinline__ void a_ready(const Unit&) const {}
    __device__ __forceinline__ void done(const Unit&) const {}
};
__device__ __forceinline__ unsigned cvt_pk_bf16(float lo, float hi) { unsigned r; asm volatile("v_cvt_pk_bf16_f32 %0, %1, %2" : "=v"(r) : "v"(lo), "v"(hi)); return r; }

struct EpiStore {
    static constexpr bool PERM = true, AFTER_DRAIN = false, APERM = false;
    bf16_t* O; int ldc; float* PART; const float* rs;
    __device__ __forceinline__ void operator()(const f32x4 (&acc)[2][2][4][2], const Unit& u, int wr, int wc, int fr, int fq) const {
        const int row0 = u.pm * BM + wr * 64 + fr, col0 = u.pn * BM + wc * 32 + 8 * fq;
        if (PART != nullptr && u.pm >= 64) {
            float* base = PART + (size_t)u.ks * 512 * ldc;
#pragma unroll
            for (int ai = 0; ai < 2; ++ai)
#pragma unroll
                for (int m = 0; m < 4; ++m) { float* rowp = base + (size_t)(row0 - 16384 + ai * HALF + m * 16) * ldc + col0;
#pragma unroll
                    for (int bj = 0; bj < 2; ++bj) { *(f32x4*)(rowp + bj * HALF) = acc[ai][bj][m][0]; *(f32x4*)(rowp + bj * HALF + 4) = acc[ai][bj][m][1]; } }
            return;
        }
#pragma unroll
        for (int ai = 0; ai < 2; ++ai)
#pragma unroll
            for (int m = 0; m < 4; ++m) { bf16_t* rowp = O + (size_t)(row0 + ai * HALF + m * 16) * ldc + col0; const float r = rs ? rs[row0 + ai * HALF + m * 16] : 1.0f;
#pragma unroll
                for (int bj = 0; bj < 2; ++bj) { const f32x4 v0 = acc[ai][bj][m][0] * r, v1 = acc[ai][bj][m][1] * r;
                    u32x4 w; w.x = cvt_pk_bf16(v0[0], v0[1]); w.y = cvt_pk_bf16(v0[2], v0[3]); w.z = cvt_pk_bf16(v1[0], v1[1]); w.w = cvt_pk_bf16(v1[2], v1[3]);
                    *(u32x4*)(rowp + bj * HALF) = w; } }
    }
};

__device__ __forceinline__ float silu_f(float x) { return x * __builtin_amdgcn_rcpf(1.0f + __expf(-x)); }

struct EpiUp {
    static constexpr bool PERM = true, AFTER_DRAIN = false, APERM = true;
    bf16_t* ACT; float* HEAD; float* TAIL; const float* cw; const float* rs;
    typedef float f32x2 __attribute__((ext_vector_type(2)));
    static __device__ __forceinline__ f32x2 shr1(f32x2 v, int src4) {
        (void)src4; const float a = v.x, b = v.y;
        f32x2 r; r.x = __int_as_float(__builtin_amdgcn_update_dpp(0, __float_as_int(a), 0x121, 0xf, 0xf, false)); r.y = __int_as_float(__builtin_amdgcn_update_dpp(0, __float_as_int(b), 0x121, 0xf, 0xf, false)); return r; }
    __device__ __forceinline__ void operator()(f32x4 (&acc)[2][2][4][2], const Unit& u, int wr, int wc, int fr, int fq) const {
        { float rr[2][4];
#pragma unroll
          for (int ai = 0; ai < 2; ++ai)
#pragma unroll
              for (int m = 0; m < 4; ++m) rr[ai][m] = rs[u.pm * BM + ai * HALF + wr * 64 + 4 * fr + m];
#pragma unroll
          for (int ai = 0; ai < 2; ++ai)
#pragma unroll
              for (int m = 0; m < 4; ++m)
#pragma unroll
                  for (int bj = 0; bj < 2; ++bj) { acc[ai][bj][m][0] *= rr[ai][m]; acc[ai][bj][m][1] *= rr[ai][m]; } }
        const int chl = wc * 32 + 8 * fq, ch0 = u.pn * 128 + chl;
        const int src4 = 4 * ((16 * fq) | ((fr + 15) & 15));
        f32x2 wgk[3], wvk[3], wgn[3], wvn[3];
#pragma unroll
        for (int k = 0; k < 3; ++k) { wgk[k] = *(const f32x2*)(cw + k * 5632 + ch0); wvk[k] = *(const f32x2*)(cw + k * 5632 + 2816 + ch0); }
        unsigned pw[2][4][4];
#pragma unroll
        for (int gi = 0; gi < 4; ++gi) {
            const int n = gi >> 1, j0 = 2 * (gi & 1);
            if (gi < 3) {
#pragma unroll
                for (int k = 0; k < 3; ++k) { wgn[k] = *(const f32x2*)(cw + k * 5632 + ch0 + 2 * (gi + 1)); wvn[k] = *(const f32x2*)(cw + k * 5632 + 2816 + ch0 + 2 * (gi + 1)); }
            }
#pragma unroll
            for (int ai = 0; ai < 2; ++ai) {
                f32x2 xg[4], xv[4];
#pragma unroll
                for (int m = 0; m < 4; ++m) { xg[m] = (f32x2){acc[ai][0][m][n][j0], acc[ai][0][m][n][j0 + 1]}; xv[m] = (f32x2){acc[ai][1][m][n][j0], acc[ai][1][m][n][j0 + 1]}; }
                const f32x2 g3 = shr1(xg[3], src4), g2 = shr1(xg[2], src4), v3 = shr1(xv[3], src4), v2 = shr1(xv[2], src4);
                f32x2 cg[4], cv[4];
                cg[0] = wgk[0] * g2 + wgk[1] * g3 + wgk[2] * xg[0];        cv[0] = wvk[0] * v2 + wvk[1] * v3 + wvk[2] * xv[0];
                cg[1] = wgk[0] * g3 + wgk[1] * xg[0] + wgk[2] * xg[1];     cv[1] = wvk[0] * v3 + wvk[1] * xv[0] + wvk[2] * xv[1];
                cg[2] = wgk[0] * xg[0] + wgk[1] * xg[1] + wgk[2] * xg[2];  cv[2] = wvk[0] * xv[0] + wvk[1] * xv[1] + wvk[2] * xv[2];
                cg[3] = wgk[0] * xg[1] + wgk[1] * xg[2] + wgk[2] * xg[3];  cv[3] = wvk[0] * xv[1] + wvk[1] * xv[2] + wvk[2] * xv[3];
#pragma unroll
                for (int m = 0; m < 4; ++m) {
                    const f32x2 t = cg[m] * (-1.4426950408889634f);
                    f32x2 e; e.x = __builtin_amdgcn_exp2f(t.x); e.y = __builtin_amdgcn_exp2f(t.y);
                    const f32x2 d = e + 1.0f;
                    f32x2 s; s.x = __builtin_amdgcn_rcpf(d.x); s.y = __builtin_amdgcn_rcpf(d.y);
                    const f32x2 o = (cg[m] * s) * cv[m];
                    pw[ai][m][gi] = cvt_pk_bf16(o.x, o.y);
                }
                __builtin_amdgcn_sched_barrier(0);
            }
            if (gi < 3) {
#pragma unroll
                for (int k = 0; k < 3; ++k) { wgk[k] = wgn[k]; wvk[k] = wvn[k]; }
            }
        }
#pragma unroll
        for (int ai = 0; ai < 2; ++ai) {
            const int blk = 4 * u.pm + 2 * ai + wr;
            if (fr == 0) {
#pragma unroll
                for (int m = 0; m < 2; ++m)
#pragma unroll
                    for (int bj = 0; bj < 2; ++bj)
#pragma unroll
                        for (int n = 0; n < 2; ++n) *(f32x4*)(HEAD + ((size_t)blk * 2 + m) * 5632 + u.pn * 256 + bj * 128 + chl + 4 * n) = acc[ai][bj][m][n];
            }
            if (fr == 15) {
#pragma unroll
                for (int m = 2; m < 4; ++m)
#pragma unroll
                    for (int bj = 0; bj < 2; ++bj)
#pragma unroll
                        for (int n = 0; n < 2; ++n) *(f32x4*)(TAIL + ((size_t)blk * 2 + (m - 2)) * 5632 + u.pn * 256 + bj * 128 + chl + 4 * n) = acc[ai][bj][m][n];
            }
#pragma unroll
            for (int m = 0; m < 4; ++m) {
                if (m >= 2 || fr > 0) {
                    u32x4 w; w.x = pw[ai][m][0]; w.y = pw[ai][m][1]; w.z = pw[ai][m][2]; w.w = pw[ai][m][3];
                    *(u32x4*)(ACT + (size_t)(64 * blk + 4 * fr + m) * 2816 + ch0) = w;
                }
            }
        }
    }
};

template <class Epi, class Sched, bool ALIGN_EPI = false, bool SP2 = false>
__device__ __forceinline__ void gemm_phase(PG8_LAS unsigned char* lds, const Gemm g, const Sched& S, const Epi& E, const int wave_s) {
    const int wid = wave_s, lane = lane_id_asm(), tid = wid * 64 + lane, wr = wid >> 2, wc = wid & 3, fr = lane & 15, fq = lane >> 4;
    const int K = g.ld;
    unsigned voffA[2], voffB[2];
#pragma unroll
    for (int i = 0; i < 2; ++i) { int R, C; stage_rc(tid * 16 + i * 8192, R, C); const int Rb = Epi::PERM ? ((R & ~31) + perm32(R & 31)) : R;
        const int Ra = Epi::APERM ? ((R & ~63) + 4 * (R & 15) + ((R & 63) >> 4)) : R;
        voffA[i] = (unsigned)(Ra * K + C) * 2u; voffB[i] = (unsigned)(Rb * K + C) * 2u; }
    const size_t kstep = (size_t)(BK * 2);
    const size_t hstep = (size_t)HALF * K * 2;
    const size_t tstep = 2 * hstep;
    const unsigned ldsw = (unsigned)wid * 1024u;
    const int aoff = lds_byte(wr * 64 + fr, fq * 8), boff = lds_byte(wc * 32 + fr, fq * 8);
#define PG8_SA(b, h) (((b) * 2 + (h)) * HTB)
#define PG8_SB(b, h) ((4 + (b) * 2 + (h)) * HTB)
#define PG8_STAGE(bufoff, gbase, voff) do { _Pragma("unroll") for (int _i = 0; _i < 2; ++_i) \
        __builtin_amdgcn_global_load_lds((const unsigned*)((const char*)(gbase) + (voff)[_i]), (PG8_LAS unsigned*)(lds + (bufoff) + ldsw + _i * 8192), 16, 0, 0); } while (0)
#define PG8_LDA(dst, b, h) do { _Pragma("unroll") for (int m = 0; m < 4; ++m) _Pragma("unroll") for (int k = 0; k < 2; ++k) dst[m][k] = *(const PG8_LAS bf16x8*)(lds + PG8_SA(b, h) + aoff + m * 2048 + k * 1024); } while (0)
#define PG8_LDB(dst, b, h) do { _Pragma("unroll") for (int n = 0; n < 2; ++n) _Pragma("unroll") for (int k = 0; k < 2; ++k) dst[n][k] = *(const PG8_LAS bf16x8*)(lds + PG8_SB(b, h) + boff + n * 2048 + k * 1024); } while (0)
#define PG8_MMA(ai, bj, At, Bt) do { __builtin_amdgcn_s_setprio(1); _Pragma("unroll") for (int m = 0; m < 4; ++m) _Pragma("unroll") for (int n = 0; n < 2; ++n) _Pragma("unroll") for (int k = 0; k < 2; ++k) \
        acc[ai][bj][m][n] = __builtin_amdgcn_mfma_f32_16x16x32_bf16(Bt[n][k], At[m][k], acc[ai][bj][m][n], 0, 0, 0); __builtin_amdgcn_s_setprio(0); } while (0)
#define PG8_WAIT_V(n) asm volatile("s_waitcnt vmcnt(" #n ")" ::: "memory")
#define PG8_WAIT_L(n) asm volatile("s_waitcnt lgkmcnt(" #n ")" ::: "memory")
#define PG8_BAR __builtin_amdgcn_s_barrier()
#define PG8_SCHED __builtin_amdgcn_sched_barrier(0)
    Unit cur, nxt; int ui = 0;
    if (!S.next(0, cur)) return;
    f32x4 acc[2][2][4][2];
#pragma unroll
    for (int a = 0; a < 2; ++a)
#pragma unroll
        for (int b = 0; b < 2; ++b)
#pragma unroll
            for (int m = 0; m < 4; ++m)
#pragma unroll
                for (int n = 0; n < 2; ++n) acc[a][b][m][n] = (f32x4){0.f, 0.f, 0.f, 0.f};
    bf16x8 At[4][2], B0[2][2], B1[2][2];
    const char* cA = (const char*)g.A + (size_t)cur.pm * tstep + (size_t)cur.k0 * kstep; const char* cB = (const char*)g.Bt + (size_t)cur.pn * tstep + (size_t)cur.k0 * kstep;
    S.a_ready(cur);
    if constexpr (SP2) {
        PG8_STAGE(PG8_SB(0, 0), cB, voffB); PG8_STAGE(PG8_SB(0, 1), cB + hstep, voffB); PG8_STAGE(PG8_SA(0, 0), cA, voffA); PG8_STAGE(PG8_SA(0, 1), cA + hstep, voffA);
        if (wr == 1) PG8_BAR;
        PG8_WAIT_V(2); PG8_BAR;
        PG8_STAGE(PG8_SB(1, 0), cB + kstep, voffB); PG8_STAGE(PG8_SA(1, 0), cA + kstep, voffA); PG8_STAGE(PG8_SB(1, 1), cB + hstep + kstep, voffB);
        PG8_WAIT_V(6); PG8_BAR;
    } else {
        PG8_STAGE(PG8_SB(0, 0), cB, voffB); PG8_STAGE(PG8_SA(0, 0), cA, voffA); PG8_STAGE(PG8_SB(0, 1), cB + hstep, voffB); PG8_STAGE(PG8_SA(0, 1), cA + hstep, voffA);
        if (wr == 1) PG8_BAR;
        PG8_WAIT_V(4); PG8_BAR;
        PG8_STAGE(PG8_SB(1, 0), cB + kstep, voffB); PG8_STAGE(PG8_SA(1, 0), cA + kstep, voffA); PG8_STAGE(PG8_SB(1, 1), cB + hstep + kstep, voffB);
        PG8_WAIT_V(6); PG8_BAR;
    }
    for (;;) {
        const bool has_next = S.next(ui + 1, nxt); const int nt = cur.nt;
        const char* nA = has_next ? (const char*)g.A + (size_t)nxt.pm * tstep + (size_t)nxt.k0 * kstep : cA; const char* nB = has_next ? (const char*)g.Bt + (size_t)nxt.pn * tstep + (size_t)nxt.k0 * kstep : cB;
        for (int t = 0; t < nt; t += 2) {
            const bool last = (t == nt - 2);
            const char* a1 = cA + (size_t)(t + 1) * kstep;
            const char* a2 = last ? nA : cA + (size_t)(t + 2) * kstep; const char* b2 = last ? nB : cB + (size_t)(t + 2) * kstep;
            const char* a3 = a2 + kstep; const char* b3 = b2 + kstep;
            if (last && has_next) S.a_ready(nxt);
            if constexpr (SP2) {
            PG8_LDB(B0, 0, 0); PG8_LDB(B1, 0, 1); PG8_SCHED; PG8_LDA(At, 0, 0); PG8_STAGE(PG8_SA(1, 1), a1 + hstep, voffA);
            PG8_WAIT_V(8); PG8_WAIT_L(0); PG8_BAR; PG8_MMA(0, 0, At, B0); PG8_MMA(0, 1, At, B1); PG8_BAR; PG8_SCHED;
            PG8_LDA(At, 0, 1); PG8_STAGE(PG8_SB(0, 0), b2, voffB); PG8_STAGE(PG8_SB(0, 1), b2 + hstep, voffB); PG8_STAGE(PG8_SA(0, 0), a2, voffA);
            PG8_WAIT_V(8); PG8_WAIT_L(0); PG8_BAR; PG8_MMA(1, 0, At, B0); PG8_MMA(1, 1, At, B1); PG8_BAR; PG8_SCHED;
            PG8_LDB(B0, 1, 0); PG8_LDB(B1, 1, 1); PG8_SCHED; PG8_LDA(At, 1, 0); PG8_STAGE(PG8_SA(0, 1), a2 + hstep, voffA);
            PG8_WAIT_V(8); PG8_WAIT_L(0); PG8_BAR; PG8_MMA(0, 0, At, B0); PG8_MMA(0, 1, At, B1); PG8_BAR; PG8_SCHED;
            PG8_LDA(At, 1, 1); PG8_STAGE(PG8_SB(1, 0), b3, voffB); PG8_STAGE(PG8_SB(1, 1), b3 + hstep, voffB); PG8_STAGE(PG8_SA(1, 0), a3, voffA);
            PG8_WAIT_V(8); PG8_WAIT_L(0); PG8_BAR; PG8_MMA(1, 0, At, B0); PG8_MMA(1, 1, At, B1); PG8_BAR; PG8_SCHED;
            } else {
            PG8_LDB(B0, 0, 0); PG8_SCHED; PG8_LDA(At, 0, 0); PG8_STAGE(PG8_SA(1, 1), a1 + hstep, voffA);
            PG8_WAIT_L(8); PG8_BAR; PG8_WAIT_L(0); PG8_MMA(0, 0, At, B0); PG8_BAR; PG8_SCHED;
            PG8_LDB(B1, 0, 1); PG8_STAGE(PG8_SB(0, 0), b2, voffB);
            PG8_BAR; PG8_WAIT_L(0); PG8_MMA(0, 1, At, B1); PG8_BAR;
            PG8_LDA(At, 0, 1); PG8_STAGE(PG8_SA(0, 0), a2, voffA);
            PG8_BAR; PG8_WAIT_L(0); PG8_MMA(1, 0, At, B0); PG8_BAR; PG8_SCHED;
            PG8_STAGE(PG8_SB(0, 1), b2 + hstep, voffB);
            PG8_WAIT_V(6); PG8_BAR; PG8_MMA(1, 1, At, B1); PG8_BAR;
            PG8_LDB(B0, 1, 0); PG8_SCHED; PG8_LDA(At, 1, 0); PG8_STAGE(PG8_SA(0, 1), a2 + hstep, voffA);
            PG8_WAIT_L(8); PG8_BAR; PG8_WAIT_L(0); PG8_MMA(0, 0, At, B0); PG8_BAR; PG8_SCHED;
            PG8_LDB(B1, 1, 1); PG8_STAGE(PG8_SB(1, 0), b3, voffB);
            PG8_BAR; PG8_WAIT_L(0); PG8_MMA(0, 1, At, B1); PG8_BAR;
            PG8_LDA(At, 1, 1); PG8_STAGE(PG8_SA(1, 0), a3, voffA);
            PG8_BAR; PG8_WAIT_L(0); PG8_MMA(1, 0, At, B0); PG8_BAR; PG8_SCHED;
            PG8_STAGE(PG8_SB(1, 1), b3 + hstep, voffB);
            PG8_WAIT_V(6); PG8_BAR; PG8_MMA(1, 1, At, B1); PG8_BAR;
            }
        }
        if constexpr (ALIGN_EPI) { if (wr == 0) PG8_BAR; }
        if constexpr (!Epi::AFTER_DRAIN) { E(acc, cur, wr, wc, fr, fq); S.done(cur); }
        if (!has_next) break;
#pragma unroll
        for (int a = 0; a < 2; ++a)
#pragma unroll
            for (int b = 0; b < 2; ++b)
#pragma unroll
                for (int m = 0; m < 4; ++m)
#pragma unroll
                    for (int n = 0; n < 2; ++n) acc[a][b][m][n] = (f32x4){0.f, 0.f, 0.f, 0.f};
        cur = nxt; cA = nA; cB = nB; ++ui;
        if constexpr (ALIGN_EPI) { if (wr == 1) PG8_BAR; }
    }
    PG8_WAIT_V(0);
    if constexpr (!ALIGN_EPI) { if (wr == 0) PG8_BAR; }
    PG8_BAR;
    if constexpr (Epi::AFTER_DRAIN) { E.fused(acc, cur, wr, wc, fr, fq, lds, wid, lane); S.done(cur); }
#undef PG8_SA
#undef PG8_SB
#undef PG8_STAGE
#undef PG8_LDA
#undef PG8_LDB
#undef PG8_MMA
#undef PG8_WAIT_V
#undef PG8_WAIT_L
#undef PG8_BAR
#undef PG8_SCHED
}
}

#define LAS __attribute__((address_space(3)))
typedef unsigned short bf16;
typedef unsigned v4u __attribute__((ext_vector_type(4)));
typedef unsigned v2u __attribute__((ext_vector_type(2)));
typedef float f32x4 __attribute__((ext_vector_type(4)));
typedef short bf16x8 __attribute__((ext_vector_type(8)));

constexpr int M = 16896, MP = 16384, D = 1024, DIN = 2048, DFF = 2816, DUP = 5632, DEPTH = 4;
constexpr float EPS = 1e-6f;
constexpr int LDS_BYTES = 147456;
constexpr size_t OUT_POOL_P = (size_t)M * D, OUT_CONV_P = OUT_POOL_P + 245760, OUT_FFN_P = OUT_CONV_P + 32768,
                 OUT_POOL_S = OUT_FFN_P + 360448, OUT_CONV_S = OUT_POOL_S + 245760, OUT_FFN_S = OUT_CONV_S + 32768, OUT_END = OUT_FFN_S + 360448;
constexpr size_t MiB = 1u << 20;
constexpr size_t WS_RS = 65536;
constexpr size_t WS_WIN = 1 * MiB, WS_WOUT = 5 * MiB, WS_WUP = 7 * MiB, WS_WDN = 18 * MiB, WS_PMT = 18 * MiB + 5767168, WS_XB = 24 * MiB;
constexpr size_t WS_Z = 57 * MiB, WS_MIXIN = 123 * MiB, WS_MIX = 156 * MiB, WS_PART = 189 * MiB;
constexpr int NS_OUT = 8, NS_DN = 11;
constexpr size_t WS_ACT = 57 * MiB, WS_HEAD = 222 * MiB, WS_TAIL = 234 * MiB, WS_END = 246 * MiB;
static_assert(WS_PMT + 4 * 16384 * 2 <= WS_XB && WS_ACT + (size_t)M * DFF * 2 <= WS_MIX && WS_HEAD + 264 * 2 * 5632 * 4 <= WS_TAIL && WS_TAIL + 264 * 2 * 5632 * 4 <= WS_END, "ws map");

struct Args { const float* in[20]; float* out; unsigned char* ws; };

#define LDS_WAIT() asm volatile("s_waitcnt lgkmcnt(0)" ::: "memory")
__device__ __forceinline__ unsigned f2bf(float f) { unsigned u = __builtin_bit_cast(unsigned, f); return (u + 0x7fffu + ((u >> 16) & 1u)) >> 16; }
__device__ __forceinline__ unsigned pk2(float lo, float hi) { unsigned r; asm("v_cvt_pk_bf16_f32 %0, %1, %2" : "=v"(r) : "v"(lo), "v"(hi)); return r; }
__device__ __forceinline__ float bflo(unsigned w) { return __uint_as_float(w << 16); }
__device__ __forceinline__ float bfhi(unsigned w) { return __uint_as_float(w & 0xffff0000u); }
__device__ __forceinline__ float wave_sum(float v) {
#pragma unroll
    for (int o = 1; o < 64; o <<= 1) v += __shfl_xor(v, o);
    return v;
}
__device__ __forceinline__ float dot4(f32x4 a) { return (a[0] * a[0] + a[1] * a[1]) + (a[2] * a[2] + a[3] * a[3]); }

__device__ __forceinline__ void transpose_item(const float* W, int K, int N, const float* gain_k0, bf16* WT, int mode, LAS float* scr, int item, int lane) {
    const int nblk = N / 32, kb = item / nblk, nb = item % nblk, k0 = 64 * kb, n0 = 32 * nb;
    { f32x4 v[8]; const int kr = lane >> 3, cc = 4 * (lane & 7);
#pragma unroll
      for (int i = 0; i < 8; ++i) v[i] = *(const f32x4*)(W + (size_t)(k0 + 8 * i + kr) * N + n0 + cc);
#pragma unroll
      for (int i = 0; i < 8; ++i) { const int kk = 8 * i + kr; const float g = gain_k0 ? gain_k0[kk] : 1.0f; LAS float* d = scr + kk * 33 + cc; d[0] = v[i][0] * g; d[1] = v[i][1] * g; d[2] = v[i][2] * g; d[3] = v[i][3] * g; } }
    LDS_WAIT(); asm volatile("" ::: "memory");
    int drow = n0;
    if (mode == 1) drow = n0 < DFF ? 256 * (n0 >> 7) + (n0 & 127) : 256 * ((n0 - DFF) >> 7) + 128 + ((n0 - DFF) & 127);
    const int c = lane & 7;
#pragma unroll
    for (int j = 0; j < 4; ++j) { const int n = (lane >> 3) + 8 * j; const LAS float* s = scr + (8 * c) * 33 + n;
        v4u o; o.x = pk2(s[0 * 33], s[1 * 33]); o.y = pk2(s[2 * 33], s[3 * 33]); o.z = pk2(s[4 * 33], s[5 * 33]); o.w = pk2(s[6 * 33], s[7 * 33]);
        *(v4u*)(WT + (size_t)(drow + n) * K + k0 + 8 * c) = o; }
    LDS_WAIT(); asm volatile("" ::: "memory");
}

__device__ __forceinline__ void convert_weights(const Args& a, int l, LAS float* scr, int gw, int NGW, int lane_) {
    const int lane = pg8::lane_id_asm(); (void)lane_;
    constexpr int I_IN = 16 * 64, I_OUT = 16 * 32, I_UP = 16 * 176, I_DN = 44 * 32, I_PM = 4 * 8, NITEMS = I_IN + I_OUT + I_UP + I_DN + I_PM;
    bf16* WIN = (bf16*)(a.ws + WS_WIN); bf16* WOUT = (bf16*)(a.ws + WS_WOUT); bf16* WUP = (bf16*)(a.ws + WS_WUP); bf16* WDN = (bf16*)(a.ws + WS_WDN); bf16* PMT = (bf16*)(a.ws + WS_PMT);
    for (int it = gw; it < NITEMS; it += NGW) {
        int r = it;
        if (r < I_IN) { const int k0 = 64 * (r / 64); transpose_item(a.in[5] + (size_t)l * D * DIN, D, DIN, a.in[12] + l * D + k0, WIN, 0, scr, r, lane); continue; } r -= I_IN;
        if (r < I_OUT) { const int k0 = 64 * (r / 32); const float* gn = k0 < 512 ? a.in[9] + l * 512 + k0 : a.in[10] + l * 512 + (k0 - 512);
            transpose_item(a.in[11] + (size_t)l * D * D, D, D, gn, WOUT, 0, scr, r, lane); continue; } r -= I_OUT;
        if (r < I_UP) { const int k0 = 64 * (r / 176); transpose_item(a.in[16] + (size_t)l * D * DUP, D, DUP, a.in[14] + l * D + k0, WUP, 1, scr, r, lane); continue; } r -= I_UP;
        if (r < I_DN) { transpose_item(a.in[18] + (size_t)l * DFF * D, DFF, D, nullptr, WDN, 0, scr, r, lane); continue; } r -= I_DN;
        const int g = r >> 3; transpose_item(a.in[6] + (size_t)(l * 4 + g) * 16384, 128, 128, nullptr, PMT + (size_t)g * 16384, 0, scr, r & 7, lane);
    }
}

__device__ __forceinline__ void x_prologue(const Args& a, int gw, int NGW, int lane_) {
    const int lane = pg8::lane_id_asm(); (void)lane_;
    bf16* XB = (bf16*)(a.ws + WS_XB); float* RS = (float*)(a.ws + WS_RS);
    for (int mb = gw; mb < M; mb += 2 * NGW) {
        f32x4 x[2][4];
#pragma unroll
        for (int r = 0; r < 2; ++r) { const int m = mb + r * NGW;
            if (m < M) { const float* src = m < MP ? a.in[0] + (size_t)m * D : a.in[1] + (size_t)(m - MP) * D;
#pragma unroll
                for (int j = 0; j < 2; ++j) { x[r][2 * j] = *(const f32x4*)(src + 8 * lane + 512 * j); x[r][2 * j + 1] = *(const f32x4*)(src + 8 * lane + 512 * j + 4); } } }
#pragma unroll
        for (int r = 0; r < 2; ++r) { const int m = mb + r * NGW;
            if (m < M) { float ss = 0.f;
#pragma unroll
                for (int j = 0; j < 4; ++j) ss += dot4(x[r][j]);
                const float rs = rsqrtf(wave_sum(ss) * (1.0f / D) + EPS);
                if (lane == 0) RS[m] = rs;
#pragma unroll
                for (int j = 0; j < 2; ++j) { v4u o; o.x = pk2(x[r][2 * j][0], x[r][2 * j][1]); o.y = pk2(x[r][2 * j][2], x[r][2 * j][3]); o.z = pk2(x[r][2 * j + 1][0], x[r][2 * j + 1][1]); o.w = pk2(x[r][2 * j + 1][2], x[r][2 * j + 1][3]);
                    *(v4u*)(XB + (size_t)m * D + 8 * lane + 512 * j) = o; } } }
    }
}

__device__ __forceinline__ void unpack8(v4u q, float (&f)[8]) { f[0] = bflo(q.x); f[1] = bfhi(q.x); f[2] = bflo(q.y); f[3] = bfhi(q.y); f[4] = bflo(q.z); f[5] = bfhi(q.z); f[6] = bflo(q.w); f[7] = bfhi(q.w); }

__device__ __forceinline__ void add8(float (&s)[8], v4u q) { s[0] += bflo(q.x); s[1] += bfhi(q.x); s[2] += bflo(q.y); s[3] += bfhi(q.y); s[4] += bflo(q.z); s[5] += bfhi(q.z); s[6] += bflo(q.w); s[7] += bfhi(q.w); }
__device__ __forceinline__ void sub8(float (&s)[8], v4u q) { s[0] -= bflo(q.x); s[1] -= bfhi(q.x); s[2] -= bflo(q.y); s[3] -= bfhi(q.y); s[4] -= bflo(q.z); s[5] -= bfhi(q.z); s[6] -= bflo(q.w); s[7] -= bfhi(q.w); }
__device__ __forceinline__ v4u pack_pool(const float (&s)[8], float inv, v4u qc) {
    v4u p; p.x = pk2(s[0] * inv - bflo(qc.x), s[1] * inv - bfhi(qc.x)); p.y = pk2(s[2] * inv - bflo(qc.y), s[3] * inv - bfhi(qc.y));
    p.z = pk2(s[4] * inv - bflo(qc.z), s[5] * inv - bfhi(qc.z)); p.w = pk2(s[6] * inv - bflo(qc.w), s[7] * inv - bfhi(qc.w)); return p; }
template <int W>
__device__ __forceinline__ void pool_rows(const bf16* Z, int seqrow0, int tb, int cg, bool sample, v4u (&pool)[4], v4u (&cur)[4]) {
    constexpr int R = W + 3;
    v4u q[R];
#pragma unroll
    for (int r = 0; r < R; ++r) { const int tr = tb - (W - 1) + r; q[r] = *(const v4u*)(Z + (size_t)(seqrow0 + (tr >= 0 ? tr : 0)) * DIN + cg); if (tr < 0) q[r] = (v4u){0u, 0u, 0u, 0u}; }
    float s[8];
#pragma unroll
    for (int i = 0; i < 8; ++i) s[i] = 0.f;
#pragma unroll
    for (int r = 0; r < W; ++r) add8(s, q[r]);
#pragma unroll
    for (int i = 0; i < 4; ++i) {
        if (i > 0) { add8(s, q[W - 1 + i]); sub8(s, q[i - 1]); }
        const int t = tb + i; const int cnt = sample ? W : (t + 1 < W ? t + 1 : W);
        cur[i] = q[W - 1 + i]; pool[i] = pack_pool(s, 1.0f / (float)cnt, cur[i]);
    }
}
__device__ __forceinline__ void pool_rows_state(const bf16* Z, const float* sp, int seqrow0, int tb, int cg, int W, v4u (&pool)[4], v4u (&cur)[4]) {
#pragma unroll
    for (int i = 0; i < 4; ++i) {
        const int t = tb + i; float s[8];
#pragma unroll
        for (int k = 0; k < 8; ++k) s[k] = 0.f;
        for (int j = 0; j < W; ++j) { const int tr = t - j;
            if (tr >= 0) add8(s, *(const v4u*)(Z + (size_t)(seqrow0 + tr) * DIN + cg));
            else { const float* p = sp + (size_t)(15 + tr) * 512 + cg; const f32x4 a0 = *(const f32x4*)p, a1 = *(const f32x4*)(p + 4);
                s[0] += a0[0]; s[1] += a0[1]; s[2] += a0[2]; s[3] += a0[3]; s[4] += a1[0]; s[5] += a1[1]; s[6] += a1[2]; s[7] += a1[3]; } }
        cur[i] = *(const v4u*)(Z + (size_t)(seqrow0 + t) * DIN + cg); pool[i] = pack_pool(s, 1.0f / (float)W, cur[i]);
    }
}

__device__ __forceinline__ void mixer_phase(const Args& a, int l, int it0, int itn, int its, int lane_, LAS unsigned char* wlds  ) {
    const int lane = pg8::lane_id_asm(); (void)lane_;
    const bf16* Z = (const bf16*)(a.ws + WS_Z); bf16* MIXIN = (bf16*)(a.ws + WS_MIXIN); const bf16* PMT = (const bf16*)(a.ws + WS_PMT);
    const float* state_pool = a.in[2]; const float* state_conv = a.in[3];
    const float* pool_scale = a.in[7] + l * 512; const float* conv_w = a.in[8] + l * 3 * 512;
    const int fr = lane & 15, fq = lane >> 4;
    for (int it = it0; it < itn; it += its) {
        const int tb = it / 5, task = it - tb * 5;
        const int m0 = tb * 16; const bool sample = m0 >= MP;
        int seq, t0, T; if (!sample) { seq = m0 >> 11; t0 = m0 & 2047; T = 2048; } else { seq = (m0 - MP) >> 6; t0 = (m0 - MP) & 63; T = 64; }
        const int seqrow0 = m0 - t0;
        if (task < 4) {
            const int g = task;
            const bool last = (t0 + 16 == T);
            float* out_pool = a.out + (sample ? OUT_POOL_S : OUT_POOL_P) + (size_t)(l * 8 + seq) * 15 * 512;
            { const int cg = g * 128 + 8 * fr, tbq = t0 + 4 * fq;
              v4u pool[4], cur[4];
              if (sample && t0 == 0) pool_rows_state(Z, state_pool + (size_t)(l * 8 + seq) * 15 * 512, seqrow0, tbq, cg, 2 << g, pool, cur);
              else if (g == 0) pool_rows<2>(Z, seqrow0, tbq, cg, sample, pool, cur);
              else if (g == 1) pool_rows<4>(Z, seqrow0, tbq, cg, sample, pool, cur);
              else if (g == 2) pool_rows<8>(Z, seqrow0, tbq, cg, sample, pool, cur);
              else pool_rows<16>(Z, seqrow0, tbq, cg, sample, pool, cur);
#pragma unroll
              for (int i = 0; i < 4; ++i) {
                  *(LAS v4u*)(wlds + (4 * fq + i) * 272 + 16 * fr) = pool[i];
                  const int ti = 4 * fq + i;
                  if (last && ti >= 1) { float* op = out_pool + (size_t)(ti - 1) * 512 + cg;
                      *(f32x4*)op = (f32x4){bflo(cur[i].x), bfhi(cur[i].x), bflo(cur[i].y), bfhi(cur[i].y)}; *(f32x4*)(op + 4) = (f32x4){bflo(cur[i].z), bfhi(cur[i].z), bflo(cur[i].w), bfhi(cur[i].w)}; }
              } }
            LDS_WAIT(); asm volatile("" ::: "memory");
            bf16x8 pf[4];
#pragma unroll
            for (int ks = 0; ks < 4; ++ks) pf[ks] = *(const LAS bf16x8*)(wlds + fr * 272 + ks * 64 + fq * 16);
            f32x4 ya[8]; float ss = 0.f;
#pragma unroll
            for (int n = 0; n < 8; ++n) {
                f32x4 acc = {0.f, 0.f, 0.f, 0.f};
                const int drow = 32 * (n >> 1) + 8 * (fr >> 2) + 4 * (n & 1) + (fr & 3);
#pragma unroll
                for (int ks = 0; ks < 4; ++ks) {
                    const bf16x8 wf = *(const bf16x8*)(PMT + (size_t)g * 16384 + (size_t)drow * 128 + ks * 32 + fq * 8);
                    acc = __builtin_amdgcn_mfma_f32_16x16x32_bf16(wf, pf[ks], acc, 0, 0, 0);
                }
                const f32x4 sc = *(const f32x4*)(pool_scale + g * 128 + 32 * (n >> 1) + 8 * fq + 4 * (n & 1));
                acc = acc * sc; ya[n] = acc; ss += dot4(acc);
            }
            ss += __shfl_xor(ss, 16); ss += __shfl_xor(ss, 32);
            const float rs = rsqrtf(ss * (1.0f / 128.0f) + EPS);
#pragma unroll
            for (int np = 0; np < 4; ++np) { v4u o; o.x = pk2(ya[2 * np][0] * rs, ya[2 * np][1] * rs); o.y = pk2(ya[2 * np][2] * rs, ya[2 * np][3] * rs); o.z = pk2(ya[2 * np + 1][0] * rs, ya[2 * np + 1][1] * rs); o.w = pk2(ya[2 * np + 1][2] * rs, ya[2 * np + 1][3] * rs);
                *(v4u*)(MIXIN + (size_t)(m0 + fr) * D + g * 128 + 32 * np + 8 * fq) = o; }
            LDS_WAIT(); asm volatile("" ::: "memory");
        } else {
            const int c0 = lane * 8;
            float* out_conv = a.out + (sample ? OUT_CONV_S : OUT_CONV_P) + (size_t)(l * 8 + seq) * 2 * 512;
            float w0[8], w1[8], w2[8], cm2[8], cm1[8];
            { const f32x4 q0 = *(const f32x4*)(conv_w + c0), q1 = *(const f32x4*)(conv_w + c0 + 4); w0[0] = q0[0]; w0[1] = q0[1]; w0[2] = q0[2]; w0[3] = q0[3]; w0[4] = q1[0]; w0[5] = q1[1]; w0[6] = q1[2]; w0[7] = q1[3]; }
            { const f32x4 q0 = *(const f32x4*)(conv_w + 512 + c0), q1 = *(const f32x4*)(conv_w + 512 + c0 + 4); w1[0] = q0[0]; w1[1] = q0[1]; w1[2] = q0[2]; w1[3] = q0[3]; w1[4] = q1[0]; w1[5] = q1[1]; w1[6] = q1[2]; w1[7] = q1[3]; }
            { const f32x4 q0 = *(const f32x4*)(conv_w + 1024 + c0), q1 = *(const f32x4*)(conv_w + 1024 + c0 + 4); w2[0] = q0[0]; w2[1] = q0[1]; w2[2] = q0[2]; w2[3] = q0[3]; w2[4] = q1[0]; w2[5] = q1[1]; w2[6] = q1[2]; w2[7] = q1[3]; }
            if (t0 > 0) {
                float gc[8], u[8];
                unpack8(*(const v4u*)(Z + (size_t)(m0 - 2) * DIN + 1024 + c0), gc); unpack8(*(const v4u*)(Z + (size_t)(m0 - 2) * DIN + 1536 + c0), u);
#pragma unroll
                for (int i = 0; i < 8; ++i) cm2[i] = gc[i] * u[i];
                unpack8(*(const v4u*)(Z + (size_t)(m0 - 1) * DIN + 1024 + c0), gc); unpack8(*(const v4u*)(Z + (size_t)(m0 - 1) * DIN + 1536 + c0), u);
#pragma unroll
                for (int i = 0; i < 8; ++i) cm1[i] = gc[i] * u[i];
            } else if (sample) {
                const float* sp = state_conv + (size_t)(l * 8 + seq) * 2 * 512 + c0;
                const f32x4 a0 = *(const f32x4*)sp, a1 = *(const f32x4*)(sp + 4), b0 = *(const f32x4*)(sp + 512), b1 = *(const f32x4*)(sp + 516);
                cm2[0] = a0[0]; cm2[1] = a0[1]; cm2[2] = a0[2]; cm2[3] = a0[3]; cm2[4] = a1[0]; cm2[5] = a1[1]; cm2[6] = a1[2]; cm2[7] = a1[3];
                cm1[0] = b0[0]; cm1[1] = b0[1]; cm1[2] = b0[2]; cm1[3] = b0[3]; cm1[4] = b1[0]; cm1[5] = b1[1]; cm1[6] = b1[2]; cm1[7] = b1[3];
            } else {
#pragma unroll
                for (int i = 0; i < 8; ++i) { cm2[i] = 0.f; cm1[i] = 0.f; }
            }
#pragma unroll 1
            for (int ib = 0; ib < 16; ib += 8) {
                v4u qb[8], qc[8], qu[8];
#pragma unroll
                for (int ii = 0; ii < 8; ++ii) { const size_t row = (size_t)(m0 + ib + ii); qb[ii] = *(const v4u*)(Z + row * DIN + 512 + c0); qc[ii] = *(const v4u*)(Z + row * DIN + 1024 + c0); qu[ii] = *(const v4u*)(Z + row * DIN + 1536 + c0); }
#pragma unroll
                for (int ii = 0; ii < 8; ++ii) {
                    const int i = ib + ii, t = t0 + i; const size_t row = (size_t)(m0 + i);
                    float gb[8], gc[8], u[8], cu[8], yb[8];
                    unpack8(qb[ii], gb); unpack8(qc[ii], gc); unpack8(qu[ii], u);
                    float ss = 0.f;
#pragma unroll
                    for (int k = 0; k < 8; ++k) { cu[k] = gc[k] * u[k]; const float co = w0[k] * cm2[k] + w1[k] * cm1[k] + w2[k] * cu[k]; yb[k] = gb[k] * co; ss += yb[k] * yb[k]; }
                    ss += __shfl_xor(ss, 1); ss += __shfl_xor(ss, 2); ss += __shfl_xor(ss, 4);
                    const float rs = rsqrtf(ss * (1.0f / 64.0f) + EPS);
                    v4u o; o.x = pk2(yb[0] * rs, yb[1] * rs); o.y = pk2(yb[2] * rs, yb[3] * rs); o.z = pk2(yb[4] * rs, yb[5] * rs); o.w = pk2(yb[6] * rs, yb[7] * rs);
                    *(v4u*)(MIXIN + row * D + 512 + c0) = o;
                    if (t >= T - 2) { float* op = out_conv + (size_t)(t - (T - 2)) * 512 + c0; *(f32x4*)op = (f32x4){cu[0], cu[1], cu[2], cu[3]}; *(f32x4*)(op + 4) = (f32x4){cu[4], cu[5], cu[6], cu[7]}; }
#pragma unroll
                    for (int k = 0; k < 8; ++k) { cm2[k] = cm1[k]; cm1[k] = cu[k]; }
                }
            }
        }
    }
}

__device__ __forceinline__ void xupd_phase(const Args& a, const float* gpost, int nparts, bool final_, int gw, int NGW, int lane_, int m_lo = 0) {
    const int lane = pg8::lane_id_asm(); (void)lane_;
    const bf16* P = (const bf16*)(a.ws + WS_MIX); const float* PART = (const float*)(a.ws + WS_PART); bf16* XB = (bf16*)(a.ws + WS_XB); float* RS = (float*)(a.ws + WS_RS); const float* gfin = a.in[19];
    for (int mb = m_lo + gw; mb < M; mb += 2 * NGW) {
        float x[2][16], mx[2][16]; float ss[2] = {0.f, 0.f};
#pragma unroll
        for (int r = 0; r < 2; ++r) {
            const int m = mb + r * NGW;
            if (m < M) {
#pragma unroll
                for (int j = 0; j < 2; ++j) { float f[8]; unpack8(*(const v4u*)(XB + (size_t)m * D + 8 * lane + 512 * j), f);
#pragma unroll
                    for (int i = 0; i < 8; ++i) x[r][8 * j + i] = f[i]; }
                if (m < MP) {
#pragma unroll
                    for (int j = 0; j < 2; ++j) { float f[8]; unpack8(*(const v4u*)(P + (size_t)m * D + 8 * lane + 512 * j), f);
#pragma unroll
                        for (int i = 0; i < 8; ++i) mx[r][8 * j + i] = f[i]; }
                } else {
#pragma unroll
                    for (int i = 0; i < 16; ++i) mx[r][i] = 0.f;
                    for (int k0 = 0; k0 < nparts; k0 += 4) {
                        f32x4 pq[4][4];
#pragma unroll
                        for (int kk = 0; kk < 4; ++kk)
#pragma unroll
                            for (int j = 0; j < 2; ++j) { const int k = (k0 + kk < nparts) ? k0 + kk : k0; const float* pp = PART + ((size_t)k * 512 + (m - MP)) * D + 8 * lane + 512 * j; pq[kk][2 * j] = *(const f32x4*)pp; pq[kk][2 * j + 1] = *(const f32x4*)(pp + 4); }
#pragma unroll
                        for (int kk = 0; kk < 4; ++kk) { const float w = (k0 + kk < nparts) ? 1.0f : 0.0f;
#pragma unroll
                            for (int j = 0; j < 2; ++j)
#pragma unroll
                                for (int i = 0; i < 4; ++i) { mx[r][8 * j + i] += w * pq[kk][2 * j][i]; mx[r][8 * j + 4 + i] += w * pq[kk][2 * j + 1][i]; } }
                    }
                }
#pragma unroll
                for (int i = 0; i < 16; ++i) ss[r] += mx[r][i] * mx[r][i];
            }
        }
#pragma unroll
        for (int r = 0; r < 2; ++r) {
            const int m = mb + r * NGW;
            if (m < M) {
                const float rs = rsqrtf(wave_sum(ss[r]) * (1.0f / D) + EPS);
                float ss2 = 0.f;
#pragma unroll
                for (int j = 0; j < 2; ++j) { const float* gp = gpost + 8 * lane + 512 * j; const f32x4 g0 = *(const f32x4*)gp, g1 = *(const f32x4*)(gp + 4);
#pragma unroll
                    for (int i = 0; i < 4; ++i) { x[r][8 * j + i] += mx[r][8 * j + i] * rs * g0[i]; x[r][8 * j + 4 + i] += mx[r][8 * j + 4 + i] * rs * g1[i]; } }
#pragma unroll
                for (int i = 0; i < 16; ++i) ss2 += x[r][i] * x[r][i];
                const float rs2 = rsqrtf(wave_sum(ss2) * (1.0f / D) + EPS);
                if (final_) {
#pragma unroll
                    for (int j = 0; j < 2; ++j) { const float* gp = gfin + 8 * lane + 512 * j; const f32x4 g0 = *(const f32x4*)gp, g1 = *(const f32x4*)(gp + 4); float* yo = a.out + (size_t)m * D + 8 * lane + 512 * j;
                        *(f32x4*)yo = (f32x4){x[r][8 * j + 0] * rs2 * g0[0], x[r][8 * j + 1] * rs2 * g0[1], x[r][8 * j + 2] * rs2 * g0[2], x[r][8 * j + 3] * rs2 * g0[3]};
                        *(f32x4*)(yo + 4) = (f32x4){x[r][8 * j + 4] * rs2 * g1[0], x[r][8 * j + 5] * rs2 * g1[1], x[r][8 * j + 6] * rs2 * g1[2], x[r][8 * j + 7] * rs2 * g1[3]}; }
                } else {
#pragma unroll
                    for (int j = 0; j < 2; ++j) { v4u o; o.x = pk2(x[r][8 * j + 0], x[r][8 * j + 1]); o.y = pk2(x[r][8 * j + 2], x[r][8 * j + 3]); o.z = pk2(x[r][8 * j + 4], x[r][8 * j + 5]); o.w = pk2(x[r][8 * j + 6], x[r][8 * j + 7]);
                        *(v4u*)(XB + (size_t)m * D + 8 * lane + 512 * j) = o; }
                    if (lane == 0) RS[m] = rs2;
                }
            }
        }
    }
}

__device__ __forceinline__ void fixup_block(const Args& a, int l, int blk, int c4) {
    const float* HEAD = (const float*)(a.ws + WS_HEAD); const float* TAIL = (const float*)(a.ws + WS_TAIL); bf16* ACT = (bf16*)(a.ws + WS_ACT);
    const float* cw = a.in[17] + (size_t)l * 3 * DUP; const float* state_ffn = a.in[4];
    const int pg = 256 * (c4 >> 7) + (c4 & 127), pv = pg + 128;
    const bool sample = blk >= 256, seqstart = sample || (blk & 31) == 0;
    f32x4 g2 = {0.f, 0.f, 0.f, 0.f}, g1 = g2, v2 = g2, v1 = g2;
    if (!seqstart) { const float* tp = TAIL + (size_t)(blk - 1) * 2 * DUP; g2 = *(const f32x4*)(tp + pg); g1 = *(const f32x4*)(tp + DUP + pg); v2 = *(const f32x4*)(tp + pv); v1 = *(const f32x4*)(tp + DUP + pv); }
    else if (sample) { const float* sp = state_ffn + (size_t)(l * 8 + (blk - 256)) * 2 * DUP; g2 = *(const f32x4*)(sp + c4); g1 = *(const f32x4*)(sp + DUP + c4); v2 = *(const f32x4*)(sp + DFF + c4); v1 = *(const f32x4*)(sp + DUP + DFF + c4); }
    const float* hp = HEAD + (size_t)blk * 2 * DUP;
    const f32x4 h0g = *(const f32x4*)(hp + pg), h1g = *(const f32x4*)(hp + DUP + pg), h0v = *(const f32x4*)(hp + pv), h1v = *(const f32x4*)(hp + DUP + pv);
    const f32x4 w0g = *(const f32x4*)(cw + c4), w1g = *(const f32x4*)(cw + DUP + c4), w2g = *(const f32x4*)(cw + 2 * DUP + c4);
    const f32x4 w0v = *(const f32x4*)(cw + DFF + c4), w1v = *(const f32x4*)(cw + DUP + DFF + c4), w2v = *(const f32x4*)(cw + 2 * DUP + DFF + c4);
    const f32x4 cg0 = w0g * g2 + w1g * g1 + w2g * h0g, cv0 = w0v * v2 + w1v * v1 + w2v * h0v;
    const f32x4 cg1 = w0g * g1 + w1g * h0g + w2g * h1g, cv1 = w0v * v1 + w1v * h0v + w2v * h1v;
    v2u o0, o1;
    o0.x = pk2(pg8::silu_f(cg0[0]) * cv0[0], pg8::silu_f(cg0[1]) * cv0[1]); o0.y = pk2(pg8::silu_f(cg0[2]) * cv0[2], pg8::silu_f(cg0[3]) * cv0[3]);
    o1.x = pk2(pg8::silu_f(cg1[0]) * cv1[0], pg8::silu_f(cg1[1]) * cv1[1]); o1.y = pk2(pg8::silu_f(cg1[2]) * cv1[2], pg8::silu_f(cg1[3]) * cv1[3]);
    *(v2u*)(ACT + (size_t)(64 * blk) * DFF + c4) = o0; *(v2u*)(ACT + (size_t)(64 * blk + 1) * DFF + c4) = o1;
}
template <class Sched>
__device__ __forceinline__ void fixup_for_units(const Args& a, int l, const Sched& S, int tid_, int gtid_, int NT) {
    const int tid = tid_ * 64 + pg8::lane_id_asm(), gtid = gtid_ * 512 + tid;
    pg8::Unit u; int prev = -1;
    for (int i = 0; S.next(i, u); ++i) {
        if (u.pm == prev) continue;
        prev = u.pm;
        for (int it = tid; it < 4 * 704; it += 512) { const int b = it / 704; fixup_block(a, l, 4 * u.pm + b, (it - b * 704) * 4); }
    }
    const float* TAIL = (const float*)(a.ws + WS_TAIL);
    for (int it = gtid; it < 16 * 2 * 1408; it += NT) {
        const int sq = it / 2816, r = it - sq * 2816, i = r / 1408, c4 = (r - i * 1408) * 4;
        const int blk = sq < 8 ? 32 * sq + 31 : 256 + (sq - 8);
        const int pc = c4 < DFF ? 256 * (c4 >> 7) + (c4 & 127) : 256 * ((c4 - DFF) >> 7) + 128 + ((c4 - DFF) & 127);
        const f32x4 v = *(const f32x4*)(TAIL + ((size_t)blk * 2 + i) * DUP + pc);
        *(f32x4*)(a.out + (sq < 8 ? OUT_FFN_P : OUT_FFN_S) + ((size_t)(l * 8 + (sq & 7)) * 2 + i) * DUP + c4) = v;
    }
    asm volatile("s_waitcnt vmcnt(0)" ::: "memory");
    __syncthreads();
    __builtin_amdgcn_fence(__ATOMIC_ACQUIRE, "agent");
}

#define XB_TMO      128
#define XB_XCNT(j)  (256  + 64 * (j))
#define XB_XSUB(j)  (1280 + 64 * (j))
#define XB_XGEN(j)  (2304 + 64 * (j))
#define XB_TOP      3328
#define XB_TOPGEN   3392
#define XCD_BAR_WORDS 3456
#define XB_SPIN_CAP (1u << 18)

__device__ __forceinline__ unsigned xb_ld(unsigned* p)              { return __hip_atomic_load(p, __ATOMIC_RELAXED, __HIP_MEMORY_SCOPE_AGENT); }
__device__ __forceinline__ unsigned xb_add(unsigned* p, unsigned v) { return __hip_atomic_fetch_add(p, v, __ATOMIC_RELAXED, __HIP_MEMORY_SCOPE_AGENT); }
__device__ __forceinline__ unsigned xb_xcc_id() { return (unsigned)__builtin_amdgcn_s_getreg((3 << 11) | 20) & 0xFu; }
#define XB_SPIN(cond, bar) do { unsigned _sp = 0; while (cond) { __builtin_amdgcn_s_sleep(1); \
    if ((++_sp & 255u) == 0u) { if (xb_ld(&(bar)[XB_TMO])) break; if (_sp > XB_SPIN_CAP) { atomicAdd(&(bar)[XB_TMO], 1u); break; } } } } while (0)

struct XcdBarrier {
    unsigned* bar; unsigned x; int wave;
    volatile LAS unsigned* st;
};

__device__ __forceinline__ XcdBarrier xcd_barrier_post(unsigned* bar, volatile LAS unsigned* st) {
    XcdBarrier b; b.bar = bar; b.x = xb_xcc_id(); b.st = st;
    if (__builtin_amdgcn_readfirstlane((int)threadIdx.x >> 6) == 0 && pg8::lane_id_asm() == 0) (void)xb_add(&bar[XB_XCNT(b.x)], 1u);
    return b;
}
__device__ __forceinline__ void xcd_barrier_complete(unsigned* bar, unsigned x, unsigned& nloc, unsigned& nx) {
    const unsigned G = gridDim.x * gridDim.y * gridDim.z;
    unsigned sum, cnt, mine, sp = 0u;
    for (;;) {
        sum = 0u; cnt = 0u; mine = 0u;
#pragma unroll
        for (unsigned j = 0; j < 16; ++j) { const unsigned c = xb_ld(&bar[XB_XCNT(j)]); sum += c; cnt += (c > 0u) ? 1u : 0u; mine = (j == x) ? c : mine; }
        if (sum == G) break;
        __builtin_amdgcn_s_sleep(1);
        if ((++sp & 255u) == 0u) { if (xb_ld(&bar[XB_TMO])) break; if (sp > XB_SPIN_CAP) { atomicAdd(&bar[XB_TMO], 1u); break; } }
    }
    nloc = mine > 0u ? mine : 1u; nx = cnt > 0u ? cnt : 1u;
}

__device__ __forceinline__ void xcd_barrier(const XcdBarrier& b) {
    asm volatile("s_waitcnt vmcnt(0)" ::: "memory");
    __syncthreads();
    if (b.wave == 0 && pg8::lane_id_asm() == 0) {
        unsigned* bar = b.bar;
        __builtin_amdgcn_s_waitcnt(0);
        unsigned nloc = b.st[0], nx = b.st[1];
        if (nloc == 0u) { xcd_barrier_complete(bar, b.x, nloc, nx); b.st[0] = nloc; b.st[1] = nx; }
        const unsigned old = xb_add(&bar[XB_XSUB(b.x)], 1u);
        const unsigned gen = old / nloc;
        if (old + 1u == (gen + 1u) * nloc) {
            __builtin_amdgcn_fence(__ATOMIC_RELEASE, "agent");
            asm volatile("s_waitcnt vmcnt(0)" ::: "memory");
            const unsigned og = xb_add(&bar[XB_TOP], 1u);
            const unsigned tg = og / nx;
            if (og + 1u == (tg + 1u) * nx) xb_add(&bar[XB_TOPGEN], 1u);
            else XB_SPIN(xb_ld(&bar[XB_TOPGEN]) == tg, bar);
            __builtin_amdgcn_fence(__ATOMIC_ACQUIRE, "agent");
            xb_add(&bar[XB_XGEN(b.x)], 1u);
            asm volatile("s_waitcnt vmcnt(0)" ::: "memory");
        } else {
            XB_SPIN(xb_ld(&bar[XB_XGEN(b.x)]) == gen, bar);
            __builtin_amdgcn_fence(__ATOMIC_ACQUIRE, "agent");
            asm volatile("s_waitcnt vmcnt(0)" ::: "memory");
        }
    }
    __syncthreads();
}

__device__ __forceinline__ void sub_barrier(unsigned* cnt, unsigned n, int wave) {
    asm volatile("s_waitcnt vmcnt(0)" ::: "memory");
    __syncthreads();
    if (wave == 0 && pg8::lane_id_asm() == 0) {
        __builtin_amdgcn_fence(__ATOMIC_RELEASE, "agent");
        asm volatile("s_waitcnt vmcnt(0)" ::: "memory");
        __hip_atomic_fetch_add(cnt, 1u, __ATOMIC_RELAXED, __HIP_MEMORY_SCOPE_AGENT);
        unsigned spins = 0;
        while (__hip_atomic_load(cnt, __ATOMIC_RELAXED, __HIP_MEMORY_SCOPE_AGENT) < n) { __builtin_amdgcn_s_sleep(2); if (++spins > (1u << 22)) break; }
        __builtin_amdgcn_fence(__ATOMIC_ACQUIRE, "agent");
        asm volatile("s_waitcnt vmcnt(0)" ::: "memory");
    }
    __syncthreads();
}
#define LAYER_BODY(l) do { \
        { \
          { pg8::Gemm g{XB, WIN, D}; pg8::MixedOrder S; S.init(DIN, D / 64, 0, G, bx); pg8::EpiStore E{Z, DIN, nullptr, (const float*)(a.ws + WS_RS)}; \
            pg8::gemm_phase<pg8::EpiStore, pg8::MixedOrder, true, true>(lds, g, S, E, wave); } \
          xcd_barrier(bar); \
          if (bx < 16) {   \
            { pg8::Gemm g{XB, WIN, D}; pg8::SampleOrder S; S.init(DIN, D / 64, bx); pg8::EpiStore E{Z, DIN, nullptr, (const float*)(a.ws + WS_RS)}; \
              pg8::gemm_phase<pg8::EpiStore, pg8::SampleOrder, true, true>(lds, g, S, E, wave); } \
            sub_barrier((unsigned*)a.ws + 3520 + 64 * l, 16u, wave); \
          } \
          mixer_phase(a, l, bx < 16 ? 5120 + bx * 8 + wave : (bx - 16) * 8 + wave, bx < 16 ? 5280 : 5120, bx < 16 ? 128 : 1920, 0, lds + wave * 16384); \
        } \
        xcd_barrier(bar); \
        { pg8::Gemm g{MIXIN, WOUT, D}; pg8::MixedOrder S; S.init(D, D / 64, NS_OUT, G, bx); pg8::EpiStore E{MIX, D, (float*)(a.ws + WS_PART), nullptr}; \
          pg8::gemm_phase<pg8::EpiStore, pg8::MixedOrder, true, true>(lds, g, S, E, wave); } \
        xcd_barrier(bar); \
        xupd_phase(a, a.in[13] + l * D, NS_OUT, false, gw, NGW, 0); \
        xcd_barrier(bar); \
        { pg8::Gemm g{XB, WUP, D}; pg8::MixedOrder S; S.init(DUP, D / 64, 1, G, bx); \
          pg8::EpiUp E{ACT, (float*)(a.ws + WS_HEAD), (float*)(a.ws + WS_TAIL), a.in[17] + (size_t)l * 3 * DUP, (const float*)(a.ws + WS_RS)}; \
          pg8::gemm_phase<pg8::EpiUp, pg8::MixedOrder, true, true>(lds, g, S, E, wave); } \
        xcd_barrier(bar); \
        { pg8::Gemm g{ACT, WDN, DFF}; pg8::MixedOrder S; S.init(D, DFF / 64, NS_DN, G, bx); pg8::EpiStore E{MIX, D, (float*)(a.ws + WS_PART), nullptr}; \
          fixup_for_units(a, l, S, wave, bx, G * 512); \
          pg8::gemm_phase<pg8::EpiStore, pg8::MixedOrder, true, true>(lds, g, S, E, wave); } \
        xcd_barrier(bar); \
        xupd_phase(a, a.in[15] + l * D, NS_DN, l == DEPTH - 1, gw, NGW, 0); \
        if (l + 1 < DEPTH) { convert_weights(a, l + 1, scr, gw, NGW, 0); xcd_barrier(bar); } \
 } while (0)
__global__ void __launch_bounds__(512, 2) fwd_megakernel(Args a) {
    extern __shared__ __attribute__((aligned(16))) unsigned char lds_raw[];
    LAS unsigned char* lds = (LAS unsigned char*)lds_raw;
    cg::grid_group grid = cg::this_grid();
    const int wave = __builtin_amdgcn_readfirstlane((int)threadIdx.x >> 6);
    const int G = gridDim.x, bx = blockIdx.x;
    const int vcu = (G % 8 == 0) ? (bx % 8) * (G / 8) + bx / 8 : bx;
    const int gw = vcu * 8 + wave, NGW = G * 8;
    LAS float* scr = (LAS float*)(lds + wave * 16384);
    bf16* XB = (bf16*)(a.ws + WS_XB); bf16* Z = (bf16*)(a.ws + WS_Z); bf16* MIXIN = (bf16*)(a.ws + WS_MIXIN); bf16* MIX = (bf16*)(a.ws + WS_MIX); bf16* ACT = (bf16*)(a.ws + WS_ACT);
    const bf16* WIN = (const bf16*)(a.ws + WS_WIN); const bf16* WOUT = (const bf16*)(a.ws + WS_WOUT); const bf16* WUP = (const bf16*)(a.ws + WS_WUP); const bf16* WDN = (const bf16*)(a.ws + WS_WDN);

    volatile LAS unsigned* bst = (volatile LAS unsigned*)(lds + 131072);
    if (threadIdx.x < 2) bst[threadIdx.x] = 0u;
    __syncthreads();
    XcdBarrier bar = xcd_barrier_post((unsigned*)a.ws, bst); bar.wave = wave;
    if (a.ws == nullptr) grid.sync();
    convert_weights(a, 0, scr, gw, NGW, 0);
    x_prologue(a, gw, NGW, 0);
    xcd_barrier(bar);
    LAYER_BODY(0); LAYER_BODY(1); LAYER_BODY(2); LAYER_BODY(3);
}

extern "C" void kernel_launch(void* const* d_in, const int* in_sizes, int n_in, void* d_out, int out_size, void* d_ws, size_t ws_size, hipStream_t stream) {
    static int grid = 0;
    if (grid == 0) {
        if (n_in != 20 || (size_t)out_size != OUT_END || ws_size < WS_END) { fprintf(stderr, "kernel_launch: unexpected shapes (n_in %d out %d ws %zu); nothing launched\n", n_in, out_size, ws_size); grid = -1; return; }
        int dev = 0, cus = 0, per_cu = 0;
        (void)hipGetDevice(&dev);
        (void)hipDeviceGetAttribute(&cus, hipDeviceAttributeMultiprocessorCount, dev);
        (void)hipFuncSetAttribute((const void*)fwd_megakernel, hipFuncAttributeMaxDynamicSharedMemorySize, LDS_BYTES);
        (void)hipOccupancyMaxActiveBlocksPerMultiprocessor(&per_cu, (const void*)fwd_megakernel, 512, LDS_BYTES);
        if (per_cu < 1) per_cu = 1;
        grid = cus * per_cu;
        if (grid != 256) { fprintf(stderr, "kernel_launch: this kernel's phase program is laid out for 256 resident workgroups (one per CU of a 256-CU device), got %d; nothing launched\n", grid); grid = -1; return; }
    }
    if (grid < 0) return;
    if (hipMemsetAsync(d_ws, 0, 16384, stream) != hipSuccess) { fprintf(stderr, "kernel_launch: hipMemsetAsync of the barrier words failed\n"); return; }
    Args a{};
    for (int i = 0; i < 20; ++i) a.in[i] = (const float*)d_in[i];
    a.out = (float*)d_out; a.ws = (unsigned char*)d_ws;
    void* args[] = {&a};
    hipError_t e = hipLaunchCooperativeKernel((const void*)fwd_megakernel, dim3(grid), dim3(512), args, LDS_BYTES, stream);
    if (e != hipSuccess) fprintf(stderr, "cooperative launch failed: %s (grid %d)\n", hipGetErrorString(e), grid);
}
```

```cpp
#include <hip/hip_runtime.h>
#include <hip/hip_cooperative_groups.h>
#include <cstdio>
#include <cstdint>
namespace cg = cooperative_groups;

namespace pg8 {
#define PG8_LAS __attribute__((address_space(3)))
typedef unsigned short bf16_t;
typedef short bf16x8 __attribute__((ext_vector_type(8)));
typedef float f32x4 __attribute__((ext_vector_type(4)));
typedef unsigned u32x4 __attribute__((ext_vector_type(4)));
constexpr int BM = 256, BK = 64, HALF = 128, HTB = HALF * BK * 2  , STAGE_BYTES = 8 * HTB, NXCD = 8, WGM = 8;

__host__ __device__ __forceinline__ int lds_byte(int r, int c) { const int st = (r >> 4) * 2 + (c >> 5), rr = r & 15, cc = c & 31, ob = rr * 64 + cc * 2; return st * 1024 + (ob ^ (((ob >> 9) & 1) << 5)); }
__host__ __device__ __forceinline__ void stage_rc(int b, int& R, int& C) { const int st = b / 1024, sb = b % 1024, swz = sb ^ (((sb >> 9) & 1) << 5); R = (st >> 1) * 16 + swz / 64; C = (st & 1) * 32 + (swz % 64) / 2; }
__host__ __device__ __forceinline__ int perm32(int rho) { const int n = rho >> 4, i = rho & 15; return 8 * (i >> 2) + 4 * n + (i & 3); }

__device__ __forceinline__ int lane_id_asm() { int l; asm volatile("v_mbcnt_lo_u32_b32 %0, -1, 0\n\tv_mbcnt_hi_u32_b32 %0, -1, %0" : "=v"(l)); return l; }
struct Unit { int pm, pn, ks, k0, nt; };
struct Gemm { const bf16_t* A; const bf16_t* Bt; int ld; };

struct MixedOrder {
    int nN, nP, nS, ntF, ntS, nwg, G, c;
    __host__ __device__ __forceinline__ void init(int N, int ntFull, int nSplit, int G_, int c_) { nN = N / BM; nP = 64 * nN; nS = nSplit; ntF = ntFull; ntS = nSplit ? ntFull / nSplit : 0; nwg = nP + 2 * nN * nS;   G = G_; c = c_; }
    __host__ __device__ __forceinline__ bool next(int i, Unit& u) const {
        const long L = (long)i * G + c; if (L >= nwg) return false;
        int wgid = (int)L;
        if (wgid < nP) {
            { const int q = nP / NXCD, xcd = wgid % NXCD, off = wgid / NXCD; wgid = xcd * q + off; }
            const int nig = WGM * nN, gid = wgid / nig, fm = gid * WGM;
            u.pm = fm + ((wgid % nig) % WGM); u.pn = (wgid % nig) / WGM; u.ks = 0; u.k0 = 0; u.nt = ntF;
        } else {
            wgid -= nP; u.ks = wgid % nS; const int t = wgid / nS; u.pm = 64 + t / nN; u.pn = t % nN; u.k0 = u.ks * ntS; u.nt = ntS;
        }
        return true;
    }
    __device__ __forceinline__ void a_ready(const Unit&) const {}
    __device__ __forceinline__ void done(const Unit&) const {}
};

struct SampleOrder {
    int nN, ntF, c;
    __host__ __device__ __forceinline__ void init(int N, int ntFull, int c_) { nN = N / BM; ntF = ntFull; c = c_; }
    __host__ __device__ __forceinline__ bool next(int i, Unit& u) const { if (i != 0 || c >= 2 * nN) return false; u.pm = 64 + c / nN; u.pn = c % nN; u.ks = 0; u.k0 = 0; u.nt = ntF; return true; }
    __device__ __forceinline__ void a_ready(const Unit&) const {}
    __device__ __forceinline__ void done(const Unit&) const {}
};
__device__ __forceinline__ unsigned cvt_pk_bf16(float lo, float hi) { unsigned r; asm volatile("v_cvt_pk_bf16_f32 %0, %1, %2" : "=v"(r) : "v"(lo), "v"(hi)); return r; }

struct EpiStore {
    static constexpr bool PERM = true, AFTER_DRAIN = false, APERM = false;
    bf16_t* O; int ldc; float* PART; const float* rs;
    __device__ __forceinline__ void operator()(const f32x4 (&acc)[2][2][4][2], const Unit& u, int wr, int wc, int fr, int fq) const {
        const int row0 = u.pm * BM + wr * 64 + fr, col0 = u.pn * BM + wc * 32 + 8 * fq;
        if (PART != nullptr && u.pm >= 64) {
            float* base = PART + (size_t)u.ks * 512 * ldc;
#pragma unroll
            for (int ai = 0; ai < 2; ++ai)
#pragma unroll
                for (int m = 0; m < 4; ++m) { float* rowp = base + (size_t)(row0 - 16384 + ai * HALF + m * 16) * ldc + col0;
#pragma unroll
                    for (int bj = 0; bj < 2; ++bj) { *(f32x4*)(rowp + bj * HALF) = acc[ai][bj][m][0]; *(f32x4*)(rowp + bj * HALF + 4) = acc[ai][bj][m][1]; } }
            return;
        }
#pragma unroll
        for (int ai = 0; ai < 2; ++ai)
#pragma unroll
            for (int m = 0; m < 4; ++m) { bf16_t* rowp = O + (size_t)(row0 + ai * HALF + m * 16) * ldc + col0; const float r = rs ? rs[row0 + ai * HALF + m * 16] : 1.0f;
#pragma unroll
                for (int bj = 0; bj < 2; ++bj) { const f32x4 v0 = acc[ai][bj][m][0] * r, v1 = acc[ai][bj][m][1] * r;
                    u32x4 w; w.x = cvt_pk_bf16(v0[0], v0[1]); w.y = cvt_pk_bf16(v0[2], v0[3]); w.z = cvt_pk_bf16(v1[0], v1[1]); w.w = cvt_pk_bf16(v1[2], v1[3]);
                    *(u32x4*)(rowp + bj * HALF) = w; } }
    }
};

__device__ __forceinline__ float silu_f(float x) { return x * __builtin_amdgcn_rcpf(1.0f + __expf(-x)); }

struct EpiUp {
    static constexpr bool PERM = true, AFTER_DRAIN = false, APERM = true;
    bf16_t* ACT; float* HEAD; float* TAIL; const float* cw; const float* rs;
    typedef float f32x2 __attribute__((ext_vector_type(2)));
    static __device__ __forceinline__ f32x2 shr1(f32x2 v, int src4) {
        (void)src4; const float a = v.x, b = v.y;
        f32x2 r; r.x = __int_as_float(__builtin_amdgcn_update_dpp(0, __float_as_int(a), 0x121, 0xf, 0xf, false)); r.y = __int_as_float(__builtin_amdgcn_update_dpp(0, __float_as_int(b), 0x121, 0xf, 0xf, false)); return r; }
    __device__ __forceinline__ void operator()(f32x4 (&acc)[2][2][4][2], const Unit& u, int wr, int wc, int fr, int fq) const {
        { float rr[2][4];
#pragma unroll
          for (int ai = 0; ai < 2; ++ai)
#pragma unroll
              for (int m = 0; m < 4; ++m) rr[ai][m] = rs[u.pm * BM + ai * HALF + wr * 64 + 4 * fr + m];
#pragma unroll
          for (int ai = 0; ai < 2; ++ai)
#pragma unroll
              for (int m = 0; m < 4; ++m)
#pragma unroll
                  for (int bj = 0; bj < 2; ++bj) { acc[ai][bj][m][0] *= rr[ai][m]; acc[ai][bj][m][1] *= rr[ai][m]; } }
        const int chl = wc * 32 + 8 * fq, ch0 = u.pn * 128 + chl;
        const int src4 = 4 * ((16 * fq) | ((fr + 15) & 15));
        f32x2 wgk[3], wvk[3], wgn[3], wvn[3];
#pragma unroll
        for (int k = 0; k < 3; ++k) { wgk[k] = *(const f32x2*)(cw + k * 5632 + ch0); wvk[k] = *(const f32x2*)(cw + k * 5632 + 2816 + ch0); }
        unsigned pw[2][4][4];
#pragma unroll
        for (int gi = 0; gi < 4; ++gi) {
            const int n = gi >> 1, j0 = 2 * (gi & 1);
            if (gi < 3) {
#pragma unroll
                for (int k = 0; k < 3; ++k) { wgn[k] = *(const f32x2*)(cw + k * 5632 + ch0 + 2 * (gi + 1)); wvn[k] = *(const f32x2*)(cw + k * 5632 + 2816 + ch0 + 2 * (gi + 1)); }
            }
#pragma unroll
            for (int ai = 0; ai < 2; ++ai) {
                f32x2 xg[4], xv[4];
#pragma unroll
                for (int m = 0; m < 4; ++m) { xg[m] = (f32x2){acc[ai][0][m][n][j0], acc[ai][0][m][n][j0 + 1]}; xv[m] = (f32x2){acc[ai][1][m][n][j0], acc[ai][1][m][n][j0 + 1]}; }
                const f32x2 g3 = shr1(xg[3], src4), g2 = shr1(xg[2], src4), v3 = shr1(xv[3], src4), v2 = shr1(xv[2], src4);
                f32x2 cg[4], cv[4];
                cg[0] = wgk[0] * g2 + wgk[1] * g3 + wgk[2] * xg[0];        cv[0] = wvk[0] * v2 + wvk[1] * v3 + wvk[2] * xv[0];
                cg[1] = wgk[0] * g3 + wgk[1] * xg[0] + wgk[2] * xg[1];     cv[1] = wvk[0] * v3 + wvk[1] * xv[0] + wvk[2] * xv[1];
                cg[2] = wgk[0] * xg[0] + wgk[1] * xg[1] + wgk[2] * xg[2];  cv[2] = wvk[0] * xv[0] + wvk[1] * xv[1] + wvk[2] * xv[2];
                cg[3] = wgk[0] * xg[1] + wgk[1] * xg[2] + wgk[2] * xg[3];  cv[3] = wvk[0] * xv[1] + wvk[1] * xv[2] + wvk[2] * xv[3];
#pragma unroll
                for (int m = 0; m < 4; ++m) {
                    const f32x2 t = cg[m] * (-1.4426950408889634f);
                    f32x2 e; e.x = __builtin_amdgcn_exp2f(t.x); e.y = __builtin_amdgcn_exp2f(t.y);
                    const f32x2 d = e + 1.0f;
                    f32x2 s; s.x = __builtin_amdgcn_rcpf(d.x); s.y = __builtin_amdgcn_rcpf(d.y);
                    const f32x2 o = (cg[m] * s) * cv[m];
                    pw[ai][m][gi] = cvt_pk_bf16(o.x, o.y);
                }
                __builtin_amdgcn_sched_barrier(0);
            }
            if (gi < 3) {
#pragma unroll
                for (int k = 0; k < 3; ++k) { wgk[k] = wgn[k]; wvk[k] = wvn[k]; }
            }
        }
#pragma unroll
        for (int ai = 0; ai < 2; ++ai) {
            const int blk = 4 * u.pm + 2 * ai + wr;
            if (fr == 0) {
#pragma unroll
                for (int m = 0; m < 2; ++m)
#pragma unroll
                    for (int bj = 0; bj < 2; ++bj)
#pragma unroll
                        for (int n = 0; n < 2; ++n) *(f32x4*)(HEAD + ((size_t)blk * 2 + m) * 5632 + u.pn * 256 + bj * 128 + chl + 4 * n) = acc[ai][bj][m][n];
            }
            if (fr == 15) {
#pragma unroll
                for (int m = 2; m < 4; ++m)
#pragma unroll
                    for (int bj = 0; bj < 2; ++bj)
#pragma unroll
                        for (int n = 0; n < 2; ++n) *(f32x4*)(TAIL + ((size_t)blk * 2 + (m - 2)) * 5632 + u.pn * 256 + bj * 128 + chl + 4 * n) = acc[ai][bj][m][n];
            }
#pragma unroll
            for (int m = 0; m < 4; ++m) {
                if (m >= 2 || fr > 0) {
                    u32x4 w; w.x = pw[ai][m][0]; w.y = pw[ai][m][1]; w.z = pw[ai][m][2]; w.w = pw[ai][m][3];
                    *(u32x4*)(ACT + (size_t)(64 * blk + 4 * fr + m) * 2816 + ch0) = w;
                }
            }
        }
    }
};

template <class Epi, class Sched, bool ALIGN_EPI = false, bool SP2 = false>
__device__ __forceinline__ void gemm_phase(PG8_LAS unsigned char* lds, const Gemm g, const Sched& S, const Epi& E, const int wave_s) {
    const int wid = wave_s, lane = lane_id_asm(), tid = wid * 64 + lane, wr = wid >> 2, wc = wid & 3, fr = lane & 15, fq = lane >> 4;
    const int K = g.ld;
    unsigned voffA[2], voffB[2];
#pragma unroll
    for (int i = 0; i < 2; ++i) { int R, C; stage_rc(tid * 16 + i * 8192, R, C); const int Rb = Epi::PERM ? ((R & ~31) + perm32(R & 31)) : R;
        const int Ra = Epi::APERM ? ((R & ~63) + 4 * (R & 15) + ((R & 63) >> 4)) : R;
        voffA[i] = (unsigned)(Ra * K + C) * 2u; voffB[i] = (unsigned)(Rb * K + C) * 2u; }
    const size_t kstep = (size_t)(BK * 2);
    const size_t hstep = (size_t)HALF * K * 2;
    const size_t tstep = 2 * hstep;
    const unsigned ldsw = (unsigned)wid * 1024u;
    const int aoff = lds_byte(wr * 64 + fr, fq * 8), boff = lds_byte(wc * 32 + fr, fq * 8);
#define PG8_SA(b, h) (((b) * 2 + (h)) * HTB)
#define PG8_SB(b, h) ((4 + (b) * 2 + (h)) * HTB)
#define PG8_STAGE(bufoff, gbase, voff) do { _Pragma("unroll") for (int _i = 0; _i < 2; ++_i) \
        __builtin_amdgcn_global_load_lds((const unsigned*)((const char*)(gbase) + (voff)[_i]), (PG8_LAS unsigned*)(lds + (bufoff) + ldsw + _i * 8192), 16, 0, 0); } while (0)
#define PG8_LDA(dst, b, h) do { _Pragma("unroll") for (int m = 0; m < 4; ++m) _Pragma("unroll") for (int k = 0; k < 2; ++k) dst[m][k] = *(const PG8_LAS bf16x8*)(lds + PG8_SA(b, h) + aoff + m * 2048 + k * 1024); } while (0)
#define PG8_LDB(dst, b, h) do { _Pragma("unroll") for (int n = 0; n < 2; ++n) _Pragma("unroll") for (int k = 0; k < 2; ++k) dst[n][k] = *(const PG8_LAS bf16x8*)(lds + PG8_SB(b, h) + boff + n * 2048 + k * 1024); } while (0)
#define PG8_MMA(ai, bj, At, Bt) do { __builtin_amdgcn_s_setprio(1); _Pragma("unroll") for (int m = 0; m < 4; ++m) _Pragma("unroll") for (int n = 0; n < 2; ++n) _Pragma("unroll") for (int k = 0; k < 2; ++k) \
        acc[ai][bj][m][n] = __builtin_amdgcn_mfma_f32_16x16x32_bf16(Bt[n][k], At[m][k], acc[ai][bj][m][n], 0, 0, 0); __builtin_amdgcn_s_setprio(0); } while (0)
#define PG8_WAIT_V(n) asm volatile("s_waitcnt vmcnt(" #n ")" ::: "memory")
#define PG8_WAIT_L(n) asm volatile("s_waitcnt lgkmcnt(" #n ")" ::: "memory")
#define PG8_BAR __builtin_amdgcn_s_barrier()
#define PG8_SCHED __builtin_amdgcn_sched_barrier(0)
    Unit cur, nxt; int ui = 0;
    if (!S.next(0, cur)) return;
    f32x4 acc[2][2][4][2];
#pragma unroll
    for (int a = 0; a < 2; ++a)
#pragma unroll
        for (int b = 0; b < 2; ++b)
#pragma unroll
            for (int m = 0; m < 4; ++m)
#pragma unroll
                for (int n = 0; n < 2; ++n) acc[a][b][m][n] = (f32x4){0.f, 0.f, 0.f, 0.f};
    bf16x8 At[4][2], B0[2][2], B1[2][2];
    const char* cA = (const char*)g.A + (size_t)cur.pm * tstep + (size_t)cur.k0 * kstep; const char* cB = (const char*)g.Bt + (size_t)cur.pn * tstep + (size_t)cur.k0 * kstep;
    S.a_ready(cur);
    if constexpr (SP2) {
        PG8_STAGE(PG8_SB(0, 0), cB, voffB); PG8_STAGE(PG8_SB(0, 1), cB + hstep, voffB); PG8_STAGE(PG8_SA(0, 0), cA, voffA); PG8_STAGE(PG8_SA(0, 1), cA + hstep, voffA);
        if (wr == 1) PG8_BAR;
        PG8_WAIT_V(2); PG8_BAR;
        PG8_STAGE(PG8_SB(1, 0), cB + kstep, voffB); PG8_STAGE(PG8_SA(1, 0), cA + kstep, voffA); PG8_STAGE(PG8_SB(1, 1), cB + hstep + kstep, voffB);
        PG8_WAIT_V(6); PG8_BAR;
    } else {
        PG8_STAGE(PG8_SB(0, 0), cB, voffB); PG8_STAGE(PG8_SA(0, 0), cA, voffA); PG8_STAGE(PG8_SB(0, 1), cB + hstep, voffB); PG8_STAGE(PG8_SA(0, 1), cA + hstep, voffA);
        if (wr == 1) PG8_BAR;
        PG8_WAIT_V(4); PG8_BAR;
        PG8_STAGE(PG8_SB(1, 0), cB + kstep, voffB); PG8_STAGE(PG8_SA(1, 0), cA + kstep, voffA); PG8_STAGE(PG8_SB(1, 1), cB + hstep + kstep, voffB);
        PG8_WAIT_V(6); PG8_BAR;
    }
    for (;;) {
        const bool has_next = S.next(ui + 1, nxt); const int nt = cur.nt;
        const char* nA = has_next ? (const char*)g.A + (size_t)nxt.pm * tstep + (size_t)nxt.k0 * kstep : cA; const char* nB = has_next ? (const char*)g.Bt + (size_t)nxt.pn * tstep + (size_t)nxt.k0 * kstep : cB;
        for (int t = 0; t < nt; t += 2) {
            const bool last = (t == nt - 2);
            const char* a1 = cA + (size_t)(t + 1) * kstep;
            const char* a2 = last ? nA : cA + (size_t)(t + 2) * kstep; const char* b2 = last ? nB : cB + (size_t)(t + 2) * kstep;
            const char* a3 = a2 + kstep; const char* b3 = b2 + kstep;
            if (last && has_next) S.a_ready(nxt);
            if constexpr (SP2) {
            PG8_LDB(B0, 0, 0); PG8_LDB(B1, 0, 1); PG8_SCHED; PG8_LDA(At, 0, 0); PG8_STAGE(PG8_SA(1, 1), a1 + hstep, voffA);
            PG8_WAIT_V(8); PG8_WAIT_L(0); PG8_BAR; PG8_MMA(0, 0, At, B0); PG8_MMA(0, 1, At, B1); PG8_BAR; PG8_SCHED;
            PG8_LDA(At, 0, 1); PG8_STAGE(PG8_SB(0, 0), b2, voffB); PG8_STAGE(PG8_SB(0, 1), b2 + hstep, voffB); PG8_STAGE(PG8_SA(0, 0), a2, voffA);
            PG8_WAIT_V(8); PG8_WAIT_L(0); PG8_BAR; PG8_MMA(1, 0, At, B0); PG8_MMA(1, 1, At, B1); PG8_BAR; PG8_SCHED;
            PG8_LDB(B0, 1, 0); PG8_LDB(B1, 1, 1); PG8_SCHED; PG8_LDA(At, 1, 0); PG8_STAGE(PG8_SA(0, 1), a2 + hstep, voffA);
            PG8_WAIT_V(8); PG8_WAIT_L(0); PG8_BAR; PG8_MMA(0, 0, At, B0); PG8_MMA(0, 1, At, B1); PG8_BAR; PG8_SCHED;
            PG8_LDA(At, 1, 1); PG8_STAGE(PG8_SB(1, 0), b3, voffB); PG8_STAGE(PG8_SB(1, 1), b3 + hstep, voffB); PG8_STAGE(PG8_SA(1, 0), a3, voffA);
            PG8_WAIT_V(8); PG8_WAIT_L(0); PG8_BAR; PG8_MMA(1, 0, At, B0); PG8_MMA(1, 1, At, B1); PG8_BAR; PG8_SCHED;
            } else {
            PG8_LDB(B0, 0, 0); PG8_SCHED; PG8_LDA(At, 0, 0); PG8_STAGE(PG8_SA(1, 1), a1 + hstep, voffA);
            PG8_WAIT_L(8); PG8_BAR; PG8_WAIT_L(0); PG8_MMA(0, 0, At, B0); PG8_BAR; PG8_SCHED;
            PG8_LDB(B1, 0, 1); PG8_STAGE(PG8_SB(0, 0), b2, voffB);
            PG8_BAR; PG8_WAIT_L(0); PG8_MMA(0, 1, At, B1); PG8_BAR;
            PG8_LDA(At, 0, 1); PG8_STAGE(PG8_SA(0, 0), a2, voffA);
            PG8_BAR; PG8_WAIT_L(0); PG8_MMA(1, 0, At, B0); PG8_BAR; PG8_SCHED;
            PG8_STAGE(PG8_SB(0, 1), b2 + hstep, voffB);
            PG8_WAIT_V(6); PG8_BAR; PG8_MMA(1, 1, At, B1); PG8_BAR;
            PG8_LDB(B0, 1, 0); PG8_SCHED; PG8_LDA(At, 1, 0); PG8_STAGE(PG8_SA(0, 1), a2 + hstep, voffA);
            PG8_WAIT_L(8); PG8_BAR; PG8_WAIT_L(0); PG8_MMA(0, 0, At, B0); PG8_BAR; PG8_SCHED;
            PG8_LDB(B1, 1, 1); PG8_STAGE(PG8_SB(1, 0), b3, voffB);
            PG8_BAR; PG8_WAIT_L(0); PG8_MMA(0, 1, At, B1); PG8_BAR;
            PG8_LDA(At, 1, 1); PG8_STAGE(PG8_SA(1, 0), a3, voffA);
            PG8_BAR; PG8_WAIT_L(0); PG8_MMA(1, 0, At, B0); PG8_BAR; PG8_SCHED;
            PG8_STAGE(PG8_SB(1, 1), b3 + hstep, voffB);
            PG8_WAIT_V(6); PG8_BAR; PG8_MMA(1, 1, At, B1); PG8_BAR;
            }
        }
        if constexpr (ALIGN_EPI) { if (wr == 0) PG8_BAR; }
        if constexpr (!Epi::AFTER_DRAIN) { E(acc, cur, wr, wc, fr, fq); S.done(cur); }
        if (!has_next) break;
#pragma unroll
        for (int a = 0; a < 2; ++a)
#pragma unroll
            for (int b = 0; b < 2; ++b)
#pragma unroll
                for (int m = 0; m < 4; ++m)
#pragma unroll
                    for (int n = 0; n < 2; ++n) acc[a][b][m][n] = (f32x4){0.f, 0.f, 0.f, 0.f};
        cur = nxt; cA = nA; cB = nB; ++ui;
        if constexpr (ALIGN_EPI) { if (wr == 1) PG8_BAR; }
    }
    PG8_WAIT_V(0);
    if constexpr (!ALIGN_EPI) { if (wr == 0) PG8_BAR; }
    PG8_BAR;
    if constexpr (Epi::AFTER_DRAIN) { E.fused(acc, cur, wr, wc, fr, fq, lds, wid, lane); S.done(cur); }
#undef PG8_SA
#undef PG8_SB
#undef PG8_STAGE
#undef PG8_LDA
#undef PG8_LDB
#undef PG8_MMA
#undef PG8_WAIT_V
#undef PG8_WAIT_L
#undef PG8_BAR
#undef PG8_SCHED
}
}

#define LAS __attribute__((address_space(3)))
typedef unsigned short bf16;
typedef unsigned v4u __attribute__((ext_vector_type(4)));
typedef unsigned v2u __attribute__((ext_vector_type(2)));
typedef float f32x4 __attribute__((ext_vector_type(4)));
typedef short bf16x8 __attribute__((ext_vector_type(8)));

constexpr int M = 16896, MP = 16384, D = 1024, DIN = 2048, DFF = 2816, DUP = 5632, DEPTH = 4;
constexpr float EPS = 1e-6f;
constexpr int LDS_BYTES = 147456;
constexpr size_t OUT_POOL_P = (size_t)M * D, OUT_CONV_P = OUT_POOL_P + 245760, OUT_FFN_P = OUT_CONV_P + 32768,
                 OUT_POOL_S = OUT_FFN_P + 360448, OUT_CONV_S = OUT_POOL_S + 245760, OUT_FFN_S = OUT_CONV_S + 32768, OUT_END = OUT_FFN_S + 360448;
constexpr size_t MiB = 1u << 20;
constexpr size_t WS_RS = 65536;
constexpr size_t WS_WIN = 1 * MiB, WS_WOUT = 5 * MiB, WS_WUP = 7 * MiB, WS_WDN = 18 * MiB, WS_PMT = 18 * MiB + 5767168, WS_XB = 24 * MiB;
constexpr size_t WS_Z = 57 * MiB, WS_MIXIN = 123 * MiB, WS_MIX = 156 * MiB, WS_PART = 189 * MiB;
constexpr int NS_OUT = 8, NS_DN = 11;
constexpr size_t WS_ACT = 57 * MiB, WS_HEAD = 222 * MiB, WS_TAIL = 234 * MiB, WS_END = 246 * MiB;
static_assert(WS_PMT + 4 * 16384 * 2 <= WS_XB && WS_ACT + (size_t)M * DFF * 2 <= WS_MIX && WS_HEAD + 264 * 2 * 5632 * 4 <= WS_TAIL && WS_TAIL + 264 * 2 * 5632 * 4 <= WS_END, "ws map");

struct Args { const float* in[20]; float* out; unsigned char* ws; };

#define LDS_WAIT() asm volatile("s_waitcnt lgkmcnt(0)" ::: "memory")
__device__ __forceinline__ unsigned f2bf(float f) { unsigned u = __builtin_bit_cast(unsigned, f); return (u + 0x7fffu + ((u >> 16) & 1u)) >> 16; }
__device__ __forceinline__ unsigned pk2(float lo, float hi) { unsigned r; asm("v_cvt_pk_bf16_f32 %0, %1, %2" : "=v"(r) : "v"(lo), "v"(hi)); return r; }
__device__ __forceinline__ float bflo(unsigned w) { return __uint_as_float(w << 16); }
__device__ __forceinline__ float bfhi(unsigned w) { return __uint_as_float(w & 0xffff0000u); }
__device__ __forceinline__ float dpp_f(float v, const int ctrl_unused) { return v; }
__device__ __forceinline__ float wave_sum(float v) {
    v += __int_as_float(__builtin_amdgcn_update_dpp(0, __float_as_int(v), 0xB1, 0xf, 0xf, false));
    v += __int_as_float(__builtin_amdgcn_update_dpp(0, __float_as_int(v), 0x4E, 0xf, 0xf, false));
    v += __int_as_float(__builtin_amdgcn_update_dpp(0, __float_as_int(v), 0x141, 0xf, 0xf, false));
    v += __int_as_float(__builtin_amdgcn_update_dpp(0, __float_as_int(v), 0x140, 0xf, 0xf, false));
    const int iv = __float_as_int(v);
    return (__int_as_float(__builtin_amdgcn_readlane(iv, 0)) + __int_as_float(__builtin_amdgcn_readlane(iv, 16))) + (__int_as_float(__builtin_amdgcn_readlane(iv, 32)) + __int_as_float(__builtin_amdgcn_readlane(iv, 48)));
}
__device__ __forceinline__ float dot4(f32x4 a) { return (a[0] * a[0] + a[1] * a[1]) + (a[2] * a[2] + a[3] * a[3]); }

__device__ __forceinline__ void transpose_item(const float* W, int K, int N, const float* gain_k0, bf16* WT, int mode, LAS float* scr, int item, int lane) {
    const int nblk = N / 32, kb = item / nblk, nb = item % nblk, k0 = 64 * kb, n0 = 32 * nb;
    { f32x4 v[8]; const int kr = lane >> 3, cc = 4 * (lane & 7);
#pragma unroll
      for (int i = 0; i < 8; ++i) v[i] = *(const f32x4*)(W + (size_t)(k0 + 8 * i + kr) * N + n0 + cc);
#pragma unroll
      for (int i = 0; i < 8; ++i) { const int kk = 8 * i + kr; const float g = gain_k0 ? gain_k0[kk] : 1.0f; LAS float* d = scr + kk * 33 + cc; d[0] = v[i][0] * g; d[1] = v[i][1] * g; d[2] = v[i][2] * g; d[3] = v[i][3] * g; } }
    LDS_WAIT(); asm volatile("" ::: "memory");
    int drow = n0;
    if (mode == 1) drow = n0 < DFF ? 256 * (n0 >> 7) + (n0 & 127) : 256 * ((n0 - DFF) >> 7) + 128 + ((n0 - DFF) & 127);
    const int c = lane & 7;
#pragma unroll
    for (int j = 0; j < 4; ++j) { const int n = (lane >> 3) + 8 * j; const LAS float* s = scr + (8 * c) * 33 + n;
        v4u o; o.x = pk2(s[0 * 33], s[1 * 33]); o.y = pk2(s[2 * 33], s[3 * 33]); o.z = pk2(s[4 * 33], s[5 * 33]); o.w = pk2(s[6 * 33], s[7 * 33]);
        *(v4u*)(WT + (size_t)(drow + n) * K + k0 + 8 * c) = o; }
    LDS_WAIT(); asm volatile("" ::: "memory");
}

__device__ __forceinline__ void convert_weights(const Args& a, int l, LAS float* scr, int gw, int NGW, int lane_) {
    const int lane = pg8::lane_id_asm(); (void)lane_;
    constexpr int I_IN = 16 * 64, I_OUT = 16 * 32, I_UP = 16 * 176, I_DN = 44 * 32, I_PM = 4 * 8, NITEMS = I_IN + I_OUT + I_UP + I_DN + I_PM;
    bf16* WIN = (bf16*)(a.ws + WS_WIN); bf16* WOUT = (bf16*)(a.ws + WS_WOUT); bf16* WUP = (bf16*)(a.ws + WS_WUP); bf16* WDN = (bf16*)(a.ws + WS_WDN); bf16* PMT = (bf16*)(a.ws + WS_PMT);
    for (int it = gw; it < NITEMS; it += NGW) {
        int r = it;
        if (r < I_IN) { const int k0 = 64 * (r / 64); transpose_item(a.in[5] + (size_t)l * D * DIN, D, DIN, a.in[12] + l * D + k0, WIN, 0, scr, r, lane); continue; } r -= I_IN;
        if (r < I_OUT) { const int k0 = 64 * (r / 32); const float* gn = k0 < 512 ? a.in[9] + l * 512 + k0 : a.in[10] + l * 512 + (k0 - 512);
            transpose_item(a.in[11] + (size_t)l * D * D, D, D, gn, WOUT, 0, scr, r, lane); continue; } r -= I_OUT;
        if (r < I_UP) { const int k0 = 64 * (r / 176); transpose_item(a.in[16] + (size_t)l * D * DUP, D, DUP, a.in[14] + l * D + k0, WUP, 1, scr, r, lane); continue; } r -= I_UP;
        if (r < I_DN) { transpose_item(a.in[18] + (size_t)l * DFF * D, DFF, D, nullptr, WDN, 0, scr, r, lane); continue; } r -= I_DN;
        const int g = r >> 3; transpose_item(a.in[6] + (size_t)(l * 4 + g) * 16384, 128, 128, nullptr, PMT + (size_t)g * 16384, 0, scr, r & 7, lane);
    }
}

__device__ __forceinline__ void x_prologue(const Args& a, int gw, int NGW, int lane_) {
    const int lane = pg8::lane_id_asm(); (void)lane_;
    bf16* XB = (bf16*)(a.ws + WS_XB); float* RS = (float*)(a.ws + WS_RS);
    for (int mb = gw; mb < M; mb += 2 * NGW) {
        f32x4 x[2][4];
#pragma unroll
        for (int r = 0; r < 2; ++r) { const int m = mb + r * NGW;
            if (m < M) { const float* src = m < MP ? a.in[0] + (size_t)m * D : a.in[1] + (size_t)(m - MP) * D;
#pragma unroll
                for (int j = 0; j < 2; ++j) { x[r][2 * j] = *(const f32x4*)(src + 8 * lane + 512 * j); x[r][2 * j + 1] = *(const f32x4*)(src + 8 * lane + 512 * j + 4); } } }
#pragma unroll
        for (int r = 0; r < 2; ++r) { const int m = mb + r * NGW;
            if (m < M) { float ss = 0.f;
#pragma unroll
                for (int j = 0; j < 4; ++j) ss += dot4(x[r][j]);
                const float rs = rsqrtf(wave_sum(ss) * (1.0f / D) + EPS);
                if (lane == 0) RS[m] = rs;
#pragma unroll
                for (int j = 0; j < 2; ++j) { v4u o; o.x = pk2(x[r][2 * j][0], x[r][2 * j][1]); o.y = pk2(x[r][2 * j][2], x[r][2 * j][3]); o.z = pk2(x[r][2 * j + 1][0], x[r][2 * j + 1][1]); o.w = pk2(x[r][2 * j + 1][2], x[r][2 * j + 1][3]);
                    *(v4u*)(XB + (size_t)m * D + 8 * lane + 512 * j) = o; } } }
    }
}

__device__ __forceinline__ void unpack8(v4u q, float (&f)[8]) { f[0] = bflo(q.x); f[1] = bfhi(q.x); f[2] = bflo(q.y); f[3] = bfhi(q.y); f[4] = bflo(q.z); f[5] = bfhi(q.z); f[6] = bflo(q.w); f[7] = bfhi(q.w); }

__device__ __forceinline__ void add8(float (&s)[8], v4u q) { s[0] += bflo(q.x); s[1] += bfhi(q.x); s[2] += bflo(q.y); s[3] += bfhi(q.y); s[4] += bflo(q.z); s[5] += bfhi(q.z); s[6] += bflo(q.w); s[7] += bfhi(q.w); }
__device__ __forceinline__ void sub8(float (&s)[8], v4u q) { s[0] -= bflo(q.x); s[1] -= bfhi(q.x); s[2] -= bflo(q.y); s[3] -= bfhi(q.y); s[4] -= bflo(q.z); s[5] -= bfhi(q.z); s[6] -= bflo(q.w); s[7] -= bfhi(q.w); }
__device__ __forceinline__ v4u pack_pool(const float (&s)[8], float inv, v4u qc) {
    v4u p; p.x = pk2(s[0] * inv - bflo(qc.x), s[1] * inv - bfhi(qc.x)); p.y = pk2(s[2] * inv - bflo(qc.y), s[3] * inv - bfhi(qc.y));
    p.z = pk2(s[4] * inv - bflo(qc.z), s[5] * inv - bfhi(qc.z)); p.w = pk2(s[6] * inv - bflo(qc.w), s[7] * inv - bfhi(qc.w)); return p; }
template <int W>
__device__ __forceinline__ void pool_rows(const bf16* Z, int seqrow0, int tb, int cg, bool sample, v4u (&pool)[4], v4u (&cur)[4]) {
    constexpr int R = W + 3;
    v4u q[R];
#pragma unroll
    for (int r = 0; r < R; ++r) { const int tr = tb - (W - 1) + r; q[r] = *(const v4u*)(Z + (size_t)(seqrow0 + (tr >= 0 ? tr : 0)) * DIN + cg); if (tr < 0) q[r] = (v4u){0u, 0u, 0u, 0u}; }
    float s[8];
#pragma unroll
    for (int i = 0; i < 8; ++i) s[i] = 0.f;
#pragma unroll
    for (int r = 0; r < W; ++r) add8(s, q[r]);
#pragma unroll
    for (int i = 0; i < 4; ++i) {
        if (i > 0) { add8(s, q[W - 1 + i]); sub8(s, q[i - 1]); }
        const int t = tb + i; const int cnt = sample ? W : (t + 1 < W ? t + 1 : W);
        cur[i] = q[W - 1 + i]; pool[i] = pack_pool(s, 1.0f / (float)cnt, cur[i]);
    }
}
__device__ __forceinline__ void pool_rows_state(const bf16* Z, const float* sp, int seqrow0, int tb, int cg, int W, v4u (&pool)[4], v4u (&cur)[4]) {
#pragma unroll
    for (int i = 0; i < 4; ++i) {
        const int t = tb + i; float s[8];
#pragma unroll
        for (int k = 0; k < 8; ++k) s[k] = 0.f;
        for (int j = 0; j < W; ++j) { const int tr = t - j;
            if (tr >= 0) add8(s, *(const v4u*)(Z + (size_t)(seqrow0 + tr) * DIN + cg));
            else { const float* p = sp + (size_t)(15 + tr) * 512 + cg; const f32x4 a0 = *(const f32x4*)p, a1 = *(const f32x4*)(p + 4);
                s[0] += a0[0]; s[1] += a0[1]; s[2] += a0[2]; s[3] += a0[3]; s[4] += a1[0]; s[5] += a1[1]; s[6] += a1[2]; s[7] += a1[3]; } }
        cur[i] = *(const v4u*)(Z + (size_t)(seqrow0 + t) * DIN + cg); pool[i] = pack_pool(s, 1.0f / (float)W, cur[i]);
    }
}

__device__ __forceinline__ void mixer_phase(const Args& a, int l, int it0, int itn, int its, int lane_, LAS unsigned char* wlds  ) {
    const int lane = pg8::lane_id_asm(); (void)lane_;
    const bf16* Z = (const bf16*)(a.ws + WS_Z); bf16* MIXIN = (bf16*)(a.ws + WS_MIXIN); const bf16* PMT = (const bf16*)(a.ws + WS_PMT);
    const float* state_pool = a.in[2]; const float* state_conv = a.in[3];
    const float* pool_scale = a.in[7] + l * 512; const float* conv_w = a.in[8] + l * 3 * 512;
    const int fr = lane & 15, fq = lane >> 4;
    for (int it = it0; it < itn; it += its) {
        const int tb = it / 5, task = it - tb * 5;
        const int m0 = tb * 16; const bool sample = m0 >= MP;
        int seq, t0, T; if (!sample) { seq = m0 >> 11; t0 = m0 & 2047; T = 2048; } else { seq = (m0 - MP) >> 6; t0 = (m0 - MP) & 63; T = 64; }
        const int seqrow0 = m0 - t0;
        if (task < 4) {
            const int g = task;
            const bool last = (t0 + 16 == T);
            float* out_pool = a.out + (sample ? OUT_POOL_S : OUT_POOL_P) + (size_t)(l * 8 + seq) * 15 * 512;
            { const int cg = g * 128 + 8 * fr, tbq = t0 + 4 * fq;
              v4u pool[4], cur[4];
              if (sample && t0 == 0) pool_rows_state(Z, state_pool + (size_t)(l * 8 + seq) * 15 * 512, seqrow0, tbq, cg, 2 << g, pool, cur);
              else if (g == 0) pool_rows<2>(Z, seqrow0, tbq, cg, sample, pool, cur);
              else if (g == 1) pool_rows<4>(Z, seqrow0, tbq, cg, sample, pool, cur);
              else if (g == 2) pool_rows<8>(Z, seqrow0, tbq, cg, sample, pool, cur);
              else pool_rows<16>(Z, seqrow0, tbq, cg, sample, pool, cur);
#pragma unroll
              for (int i = 0; i < 4; ++i) {
                  *(LAS v4u*)(wlds + (4 * fq + i) * 272 + 16 * fr) = pool[i];
                  const int ti = 4 * fq + i;
                  if (last && ti >= 1) { float* op = out_pool + (size_t)(ti - 1) * 512 + cg;
                      *(f32x4*)op = (f32x4){bflo(cur[i].x), bfhi(cur[i].x), bflo(cur[i].y), bfhi(cur[i].y)}; *(f32x4*)(op + 4) = (f32x4){bflo(cur[i].z), bfhi(cur[i].z), bflo(cur[i].w), bfhi(cur[i].w)}; }
              } }
            LDS_WAIT(); asm volatile("" ::: "memory");
            bf16x8 pf[4];
#pragma unroll
            for (int ks = 0; ks < 4; ++ks) pf[ks] = *(const LAS bf16x8*)(wlds + fr * 272 + ks * 64 + fq * 16);
            f32x4 ya[8]; float ss = 0.f;
#pragma unroll
            for (int n = 0; n < 8; ++n) {
                f32x4 acc = {0.f, 0.f, 0.f, 0.f};
                const int drow = 32 * (n >> 1) + 8 * (fr >> 2) + 4 * (n & 1) + (fr & 3);
#pragma unroll
                for (int ks = 0; ks < 4; ++ks) {
                    const bf16x8 wf = *(const bf16x8*)(PMT + (size_t)g * 16384 + (size_t)drow * 128 + ks * 32 + fq * 8);
                    acc = __builtin_amdgcn_mfma_f32_16x16x32_bf16(wf, pf[ks], acc, 0, 0, 0);
                }
                const f32x4 sc = *(const f32x4*)(pool_scale + g * 128 + 32 * (n >> 1) + 8 * fq + 4 * (n & 1));
                acc = acc * sc; ya[n] = acc; ss += dot4(acc);
            }
            ss += __shfl_xor(ss, 16); ss += __shfl_xor(ss, 32);
            const float rs = rsqrtf(ss * (1.0f / 128.0f) + EPS);
#pragma unroll
            for (int np = 0; np < 4; ++np) { v4u o; o.x = pk2(ya[2 * np][0] * rs, ya[2 * np][1] * rs); o.y = pk2(ya[2 * np][2] * rs, ya[2 * np][3] * rs); o.z = pk2(ya[2 * np + 1][0] * rs, ya[2 * np + 1][1] * rs); o.w = pk2(ya[2 * np + 1][2] * rs, ya[2 * np + 1][3] * rs);
                *(v4u*)(MIXIN + (size_t)(m0 + fr) * D + g * 128 + 32 * np + 8 * fq) = o; }
            LDS_WAIT(); asm volatile("" ::: "memory");
        } else {
            const int c0 = lane * 8;
            float* out_conv = a.out + (sample ? OUT_CONV_S : OUT_CONV_P) + (size_t)(l * 8 + seq) * 2 * 512;
            float w0[8], w1[8], w2[8], cm2[8], cm1[8];
            { const f32x4 q0 = *(const f32x4*)(conv_w + c0), q1 = *(const f32x4*)(conv_w + c0 + 4); w0[0] = q0[0]; w0[1] = q0[1]; w0[2] = q0[2]; w0[3] = q0[3]; w0[4] = q1[0]; w0[5] = q1[1]; w0[6] = q1[2]; w0[7] = q1[3]; }
            { const f32x4 q0 = *(const f32x4*)(conv_w + 512 + c0), q1 = *(const f32x4*)(conv_w + 512 + c0 + 4); w1[0] = q0[0]; w1[1] = q0[1]; w1[2] = q0[2]; w1[3] = q0[3]; w1[4] = q1[0]; w1[5] = q1[1]; w1[6] = q1[2]; w1[7] = q1[3]; }
            { const f32x4 q0 = *(const f32x4*)(conv_w + 1024 + c0), q1 = *(const f32x4*)(conv_w + 1024 + c0 + 4); w2[0] = q0[0]; w2[1] = q0[1]; w2[2] = q0[2]; w2[3] = q0[3]; w2[4] = q1[0]; w2[5] = q1[1]; w2[6] = q1[2]; w2[7] = q1[3]; }
            if (t0 > 0) {
                float gc[8], u[8];
                unpack8(*(const v4u*)(Z + (size_t)(m0 - 2) * DIN + 1024 + c0), gc); unpack8(*(const v4u*)(Z + (size_t)(m0 - 2) * DIN + 1536 + c0), u);
#pragma unroll
                for (int i = 0; i < 8; ++i) cm2[i] = gc[i] * u[i];
                unpack8(*(const v4u*)(Z + (size_t)(m0 - 1) * DIN + 1024 + c0), gc); unpack8(*(const v4u*)(Z + (size_t)(m0 - 1) * DIN + 1536 + c0), u);
#pragma unroll
                for (int i = 0; i < 8; ++i) cm1[i] = gc[i] * u[i];
            } else if (sample) {
                const float* sp = state_conv + (size_t)(l * 8 + seq) * 2 * 512 + c0;
                const f32x4 a0 = *(const f32x4*)sp, a1 = *(const f32x4*)(sp + 4), b0 = *(const f32x4*)(sp + 512), b1 = *(const f32x4*)(sp + 516);
                cm2[0] = a0[0]; cm2[1] = a0[1]; cm2[2] = a0[2]; cm2[3] = a0[3]; cm2[4] = a1[0]; cm2[5] = a1[1]; cm2[6] = a1[2]; cm2[7] = a1[3];
                cm1[0] = b0[0]; cm1[1] = b0[1]; cm1[2] = b0[2]; cm1[3] = b0[3]; cm1[4] = b1[0]; cm1[5] = b1[1]; cm1[6] = b1[2]; cm1[7] = b1[3];
            } else {
#pragma unroll
                for (int i = 0; i < 8; ++i) { cm2[i] = 0.f; cm1[i] = 0.f; }
            }
#pragma unroll 1
            for (int ib = 0; ib < 16; ib += 8) {
                v4u qb[8], qc[8], qu[8];
#pragma unroll
                for (int ii = 0; ii < 8; ++ii) { const size_t row = (size_t)(m0 + ib + ii); qb[ii] = *(const v4u*)(Z + row * DIN + 512 + c0); qc[ii] = *(const v4u*)(Z + row * DIN + 1024 + c0); qu[ii] = *(const v4u*)(Z + row * DIN + 1536 + c0); }
#pragma unroll
                for (int ii = 0; ii < 8; ++ii) {
                    const int i = ib + ii, t = t0 + i; const size_t row = (size_t)(m0 + i);
                    float gb[8], gc[8], u[8], cu[8], yb[8];
                    unpack8(qb[ii], gb); unpack8(qc[ii], gc); unpack8(qu[ii], u);
                    float ss = 0.f;
#pragma unroll
                    for (int k = 0; k < 8; ++k) { cu[k] = gc[k] * u[k]; const float co = w0[k] * cm2[k] + w1[k] * cm1[k] + w2[k] * cu[k]; yb[k] = gb[k] * co; ss += yb[k] * yb[k]; }
                    ss += __int_as_float(__builtin_amdgcn_update_dpp(0, __float_as_int(ss), 0xB1, 0xf, 0xf, false));
                    ss += __int_as_float(__builtin_amdgcn_update_dpp(0, __float_as_int(ss), 0x4E, 0xf, 0xf, false));
                    ss += __int_as_float(__builtin_amdgcn_update_dpp(0, __float_as_int(ss), 0x141, 0xf, 0xf, false));
                    const float rs = rsqrtf(ss * (1.0f / 64.0f) + EPS);
                    v4u o; o.x = pk2(yb[0] * rs, yb[1] * rs); o.y = pk2(yb[2] * rs, yb[3] * rs); o.z = pk2(yb[4] * rs, yb[5] * rs); o.w = pk2(yb[6] * rs, yb[7] * rs);
                    *(v4u*)(MIXIN + row * D + 512 + c0) = o;
                    if (t >= T - 2) { float* op = out_conv + (size_t)(t - (T - 2)) * 512 + c0; *(f32x4*)op = (f32x4){cu[0], cu[1], cu[2], cu[3]}; *(f32x4*)(op + 4) = (f32x4){cu[4], cu[5], cu[6], cu[7]}; }
#pragma unroll
                    for (int k = 0; k < 8; ++k) { cm2[k] = cm1[k]; cm1[k] = cu[k]; }
                }
            }
        }
    }
}

__device__ __forceinline__ void xupd_phase(const Args& a, const float* gpost, int nparts, bool final_, int gw, int NGW, int lane_, int m_lo = 0) {
    const int lane = pg8::lane_id_asm(); (void)lane_;
    const bf16* P = (const bf16*)(a.ws + WS_MIX); const float* PART = (const float*)(a.ws + WS_PART); bf16* XB = (bf16*)(a.ws + WS_XB); float* RS = (float*)(a.ws + WS_RS); const float* gfin = a.in[19];
    for (int mb = m_lo + gw; mb < M; mb += 2 * NGW) {
        float x[2][16], mx[2][16]; float ss[2] = {0.f, 0.f};
#pragma unroll
        for (int r = 0; r < 2; ++r) {
            const int m = mb + r * NGW;
            if (m < M) {
#pragma unroll
                for (int j = 0; j < 2; ++j) { float f[8]; unpack8(*(const v4u*)(XB + (size_t)m * D + 8 * lane + 512 * j), f);
#pragma unroll
                    for (int i = 0; i < 8; ++i) x[r][8 * j + i] = f[i]; }
                if (m < MP) {
#pragma unroll
                    for (int j = 0; j < 2; ++j) { float f[8]; unpack8(*(const v4u*)(P + (size_t)m * D + 8 * lane + 512 * j), f);
#pragma unroll
                        for (int i = 0; i < 8; ++i) mx[r][8 * j + i] = f[i]; }
                } else {
#pragma unroll
                    for (int i = 0; i < 16; ++i) mx[r][i] = 0.f;
                    for (int k0 = 0; k0 < nparts; k0 += 4) {
                        f32x4 pq[4][4];
#pragma unroll
                        for (int kk = 0; kk < 4; ++kk)
#pragma unroll
                            for (int j = 0; j < 2; ++j) { const int k = (k0 + kk < nparts) ? k0 + kk : k0; const float* pp = PART + ((size_t)k * 512 + (m - MP)) * D + 8 * lane + 512 * j; pq[kk][2 * j] = *(const f32x4*)pp; pq[kk][2 * j + 1] = *(const f32x4*)(pp + 4); }
#pragma unroll
                        for (int kk = 0; kk < 4; ++kk) { const float w = (k0 + kk < nparts) ? 1.0f : 0.0f;
#pragma unroll
                            for (int j = 0; j < 2; ++j)
#pragma unroll
                                for (int i = 0; i < 4; ++i) { mx[r][8 * j + i] += w * pq[kk][2 * j][i]; mx[r][8 * j + 4 + i] += w * pq[kk][2 * j + 1][i]; } }
                    }
                }
#pragma unroll
                for (int i = 0; i < 16; ++i) ss[r] += mx[r][i] * mx[r][i];
            }
        }
#pragma unroll
        for (int r = 0; r < 2; ++r) {
            const int m = mb + r * NGW;
            if (m < M) {
                const float rs = rsqrtf(wave_sum(ss[r]) * (1.0f / D) + EPS);
                float ss2 = 0.f;
#pragma unroll
                for (int j = 0; j < 2; ++j) { const float* gp = gpost + 8 * lane + 512 * j; const f32x4 g0 = *(const f32x4*)gp, g1 = *(const f32x4*)(gp + 4);
#pragma unroll
                    for (int i = 0; i < 4; ++i) { x[r][8 * j + i] += mx[r][8 * j + i] * rs * g0[i]; x[r][8 * j + 4 + i] += mx[r][8 * j + 4 + i] * rs * g1[i]; } }
#pragma unroll
                for (int i = 0; i < 16; ++i) ss2 += x[r][i] * x[r][i];
                const float rs2 = rsqrtf(wave_sum(ss2) * (1.0f / D) + EPS);
                if (final_) {
#pragma unroll
                    for (int j = 0; j < 2; ++j) { const float* gp = gfin + 8 * lane + 512 * j; const f32x4 g0 = *(const f32x4*)gp, g1 = *(const f32x4*)(gp + 4); float* yo = a.out + (size_t)m * D + 8 * lane + 512 * j;
                        *(f32x4*)yo = (f32x4){x[r][8 * j + 0] * rs2 * g0[0], x[r][8 * j + 1] * rs2 * g0[1], x[r][8 * j + 2] * rs2 * g0[2], x[r][8 * j + 3] * rs2 * g0[3]};
                        *(f32x4*)(yo + 4) = (f32x4){x[r][8 * j + 4] * rs2 * g1[0], x[r][8 * j + 5] * rs2 * g1[1], x[r][8 * j + 6] * rs2 * g1[2], x[r][8 * j + 7] * rs2 * g1[3]}; }
                } else {
#pragma unroll
                    for (int j = 0; j < 2; ++j) { v4u o; o.x = pk2(x[r][8 * j + 0], x[r][8 * j + 1]); o.y = pk2(x[r][8 * j + 2], x[r][8 * j + 3]); o.z = pk2(x[r][8 * j + 4], x[r][8 * j + 5]); o.w = pk2(x[r][8 * j + 6], x[r][8 * j + 7]);
                        *(v4u*)(XB + (size_t)m * D + 8 * lane + 512 * j) = o; }
                    if (lane == 0) RS[m] = rs2;
                }
            }
        }
    }
}

__device__ __forceinline__ void fixup_block(const Args& a, int l, int blk, int c4) {
    const float* HEAD = (const float*)(a.ws + WS_HEAD); const float* TAIL = (const float*)(a.ws + WS_TAIL); bf16* ACT = (bf16*)(a.ws + WS_ACT);
    const float* cw = a.in[17] + (size_t)l * 3 * DUP; const float* state_ffn = a.in[4];
    const int pg = 256 * (c4 >> 7) + (c4 & 127), pv = pg + 128;
    const bool sample = blk >= 256, seqstart = sample || (blk & 31) == 0;
    f32x4 g2 = {0.f, 0.f, 0.f, 0.f}, g1 = g2, v2 = g2, v1 = g2;
    if (!seqstart) { const float* tp = TAIL + (size_t)(blk - 1) * 2 * DUP; g2 = *(const f32x4*)(tp + pg); g1 = *(const f32x4*)(tp + DUP + pg); v2 = *(const f32x4*)(tp + pv); v1 = *(const f32x4*)(tp + DUP + pv); }
    else if (sample) { const float* sp = state_ffn + (size_t)(l * 8 + (blk - 256)) * 2 * DUP; g2 = *(const f32x4*)(sp + c4); g1 = *(const f32x4*)(sp + DUP + c4); v2 = *(const f32x4*)(sp + DFF + c4); v1 = *(const f32x4*)(sp + DUP + DFF + c4); }
    const float* hp = HEAD + (size_t)blk * 2 * DUP;
    const f32x4 h0g = *(const f32x4*)(hp + pg), h1g = *(const f32x4*)(hp + DUP + pg), h0v = *(const f32x4*)(hp + pv), h1v = *(const f32x4*)(hp + DUP + pv);
    const f32x4 w0g = *(const f32x4*)(cw + c4), w1g = *(const f32x4*)(cw + DUP + c4), w2g = *(const f32x4*)(cw + 2 * DUP + c4);
    const f32x4 w0v = *(const f32x4*)(cw + DFF + c4), w1v = *(const f32x4*)(cw + DUP + DFF + c4), w2v = *(const f32x4*)(cw + 2 * DUP + DFF + c4);
    const f32x4 cg0 = w0g * g2 + w1g * g1 + w2g * h0g, cv0 = w0v * v2 + w1v * v1 + w2v * h0v;
    const f32x4 cg1 = w0g * g1 + w1g * h0g + w2g * h1g, cv1 = w0v * v1 + w1v * h0v + w2v * h1v;
    v2u o0, o1;
    o0.x = pk2(pg8::silu_f(cg0[0]) * cv0[0], pg8::silu_f(cg0[1]) * cv0[1]); o0.y = pk2(pg8::silu_f(cg0[2]) * cv0[2], pg8::silu_f(cg0[3]) * cv0[3]);
    o1.x = pk2(pg8::silu_f(cg1[0]) * cv1[0], pg8::silu_f(cg1[1]) * cv1[1]); o1.y = pk2(pg8::silu_f(cg1[2]) * cv1[2], pg8::silu_f(cg1[3]) * cv1[3]);
    *(v2u*)(ACT + (size_t)(64 * blk) * DFF + c4) = o0; *(v2u*)(ACT + (size_t)(64 * blk + 1) * DFF + c4) = o1;
}
template <class Sched>
__device__ __forceinline__ void fixup_for_units(const Args& a, int l, const Sched& S, int tid_, int gtid_, int NT) {
    const int tid = tid_ * 64 + pg8::lane_id_asm(), gtid = gtid_ * 512 + tid;
    pg8::Unit u; int prev = -1;
    for (int i = 0; S.next(i, u); ++i) {
        if (u.pm == prev) continue;
        prev = u.pm;
        for (int it = tid; it < 4 * 704; it += 512) { const int b = it / 704; fixup_block(a, l, 4 * u.pm + b, (it - b * 704) * 4); }
    }
    const float* TAIL = (const float*)(a.ws + WS_TAIL);
    for (int it = gtid; it < 16 * 2 * 1408; it += NT) {
        const int sq = it / 2816, r = it - sq * 2816, i = r / 1408, c4 = (r - i * 1408) * 4;
        const int blk = sq < 8 ? 32 * sq + 31 : 256 + (sq - 8);
        const int pc = c4 < DFF ? 256 * (c4 >> 7) + (c4 & 127) : 256 * ((c4 - DFF) >> 7) + 128 + ((c4 - DFF) & 127);
        const f32x4 v = *(const f32x4*)(TAIL + ((size_t)blk * 2 + i) * DUP + pc);
        *(f32x4*)(a.out + (sq < 8 ? OUT_FFN_P : OUT_FFN_S) + ((size_t)(l * 8 + (sq & 7)) * 2 + i) * DUP + c4) = v;
    }
    asm volatile("s_waitcnt vmcnt(0)" ::: "memory");
    __syncthreads();
    __builtin_amdgcn_fence(__ATOMIC_ACQUIRE, "agent");
}

#define XB_TMO      128
#define XB_XCNT(j)  (256  + 64 * (j))
#define XB_XSUB(j)  (1280 + 64 * (j))
#define XB_XGEN(j)  (2304 + 64 * (j))
#define XB_TOP      3328
#define XB_TOPGEN   3392
#define XCD_BAR_WORDS 3456
#define XB_SPIN_CAP (1u << 18)

__device__ __forceinline__ unsigned xb_ld(unsigned* p)              { return __hip_atomic_load(p, __ATOMIC_RELAXED, __HIP_MEMORY_SCOPE_AGENT); }
__device__ __forceinline__ unsigned xb_add(unsigned* p, unsigned v) { return __hip_atomic_fetch_add(p, v, __ATOMIC_RELAXED, __HIP_MEMORY_SCOPE_AGENT); }
__device__ __forceinline__ unsigned xb_xcc_id() { return (unsigned)__builtin_amdgcn_s_getreg((3 << 11) | 20) & 0xFu; }
#define XB_SPIN(cond, bar) do { unsigned _sp = 0; while (cond) { __builtin_amdgcn_s_sleep(1); \
    if ((++_sp & 255u) == 0u) { if (xb_ld(&(bar)[XB_TMO])) break; if (_sp > XB_SPIN_CAP) { atomicAdd(&(bar)[XB_TMO], 1u); break; } } } } while (0)

struct XcdBarrier {
    unsigned* bar; unsigned x; int wave;
    volatile LAS unsigned* st;
};

__device__ __forceinline__ XcdBarrier xcd_barrier_post(unsigned* bar, volatile LAS unsigned* st) {
    XcdBarrier b; b.bar = bar; b.x = xb_xcc_id(); b.st = st;
    if (__builtin_amdgcn_readfirstlane((int)threadIdx.x >> 6) == 0 && pg8::lane_id_asm() == 0) (void)xb_add(&bar[XB_XCNT(b.x)], 1u);
    return b;
}
__device__ __forceinline__ void xcd_barrier_complete(unsigned* bar, unsigned x, unsigned& nloc, unsigned& nx) {
    const unsigned G = gridDim.x * gridDim.y * gridDim.z;
    unsigned sum, cnt, mine, sp = 0u;
    for (;;) {
        sum = 0u; cnt = 0u; mine = 0u;
#pragma unroll
        for (unsigned j = 0; j < 16; ++j) { const unsigned c = xb_ld(&bar[XB_XCNT(j)]); sum += c; cnt += (c > 0u) ? 1u : 0u; mine = (j == x) ? c : mine; }
        if (sum == G) break;
        __builtin_amdgcn_s_sleep(1);
        if ((++sp & 255u) == 0u) { if (xb_ld(&bar[XB_TMO])) break; if (sp > XB_SPIN_CAP) { atomicAdd(&bar[XB_TMO], 1u); break; } }
    }
    nloc = mine > 0u ? mine : 1u; nx = cnt > 0u ? cnt : 1u;
}

__device__ __forceinline__ void xcd_barrier(const XcdBarrier& b) {
    asm volatile("s_waitcnt vmcnt(0)" ::: "memory");
    __syncthreads();
    if (b.wave == 0 && pg8::lane_id_asm() == 0) {
        unsigned* bar = b.bar;
        __builtin_amdgcn_s_waitcnt(0);
        unsigned nloc = b.st[0], nx = b.st[1];
        if (nloc == 0u) { xcd_barrier_complete(bar, b.x, nloc, nx); b.st[0] = nloc; b.st[1] = nx; }
        const unsigned old = xb_add(&bar[XB_XSUB(b.x)], 1u);
        const unsigned gen = old / nloc;
        if (old + 1u == (gen + 1u) * nloc) {
            __builtin_amdgcn_fence(__ATOMIC_RELEASE, "agent");
            asm volatile("s_waitcnt vmcnt(0)" ::: "memory");
            const unsigned og = xb_add(&bar[XB_TOP], 1u);
            const unsigned tg = og / nx;
            if (og + 1u == (tg + 1u) * nx) xb_add(&bar[XB_TOPGEN], 1u);
            else XB_SPIN(xb_ld(&bar[XB_TOPGEN]) == tg, bar);
            __builtin_amdgcn_fence(__ATOMIC_ACQUIRE, "agent");
            xb_add(&bar[XB_XGEN(b.x)], 1u);
            asm volatile("s_waitcnt vmcnt(0)" ::: "memory");
        } else {
            XB_SPIN(xb_ld(&bar[XB_XGEN(b.x)]) == gen, bar);
            __builtin_amdgcn_fence(__ATOMIC_ACQUIRE, "agent");
            asm volatile("s_waitcnt vmcnt(0)" ::: "memory");
        }
    }
    __syncthreads();
}

__device__ __forceinline__ void sub_barrier(unsigned* cnt, unsigned n, int wave) {
    asm volatile("s_waitcnt vmcnt(0)" ::: "memory");
    __syncthreads();
    if (wave == 0 && pg8::lane_id_asm() == 0) {
        __builtin_amdgcn_fence(__ATOMIC_RELEASE, "agent");
        asm volatile("s_waitcnt vmcnt(0)" ::: "memory");
        __hip_atomic_fetch_add(cnt, 1u, __ATOMIC_RELAXED, __HIP_MEMORY_SCOPE_AGENT);
        unsigned spins = 0;
        while (__hip_atomic_load(cnt, __ATOMIC_RELAXED, __HIP_MEMORY_SCOPE_AGENT) < n) { __builtin_amdgcn_s_sleep(2); if (++spins > (1u << 22)) break; }
        __builtin_amdgcn_fence(__ATOMIC_ACQUIRE, "agent");
        asm volatile("s_waitcnt vmcnt(0)" ::: "memory");
    }
    __syncthreads();
}
#define LAYER_BODY(l) do { \
        { \
          { pg8::Gemm g{XB, WIN, D}; pg8::MixedOrder S; S.init(DIN, D / 64, 0, G, bx); pg8::EpiStore E{Z, DIN, nullptr, (const float*)(a.ws + WS_RS)}; \
            pg8::gemm_phase<pg8::EpiStore, pg8::MixedOrder, true, true>(lds, g, S, E, wave); } \
          xcd_barrier(bar); \
          if (bx < 16) {   \
            { pg8::Gemm g{XB, WIN, D}; pg8::SampleOrder S; S.init(DIN, D / 64, bx); pg8::EpiStore E{Z, DIN, nullptr, (const float*)(a.ws + WS_RS)}; \
              pg8::gemm_phase<pg8::EpiStore, pg8::SampleOrder, true, true>(lds, g, S, E, wave); } \
            sub_barrier((unsigned*)a.ws + 3520 + 64 * l, 16u, wave); \
          } \
          mixer_phase(a, l, bx < 16 ? 5120 + bx * 8 + wave : (bx - 16) * 8 + wave, bx < 16 ? 5280 : 5120, bx < 16 ? 128 : 1920, 0, lds + wave * 16384); \
        } \
        xcd_barrier(bar); \
        { pg8::Gemm g{MIXIN, WOUT, D}; pg8::MixedOrder S; S.init(D, D / 64, NS_OUT, G, bx); pg8::EpiStore E{MIX, D, (float*)(a.ws + WS_PART), nullptr}; \
          pg8::gemm_phase<pg8::EpiStore, pg8::MixedOrder, true, true>(lds, g, S, E, wave); } \
        xcd_barrier(bar); \
        xupd_phase(a, a.in[13] + l * D, NS_OUT, false, gw, NGW, 0); \
        xcd_barrier(bar); \
        { pg8::Gemm g{XB, WUP, D}; pg8::MixedOrder S; S.init(DUP, D / 64, 1, G, bx); \
          pg8::EpiUp E{ACT, (float*)(a.ws + WS_HEAD), (float*)(a.ws + WS_TAIL), a.in[17] + (size_t)l * 3 * DUP, (const float*)(a.ws + WS_RS)}; \
          pg8::gemm_phase<pg8::EpiUp, pg8::MixedOrder, true, true>(lds, g, S, E, wave); } \
        xcd_barrier(bar); \
        { pg8::Gemm g{ACT, WDN, DFF}; pg8::MixedOrder S; S.init(D, DFF / 64, NS_DN, G, bx); pg8::EpiStore E{MIX, D, (float*)(a.ws + WS_PART), nullptr}; \
          fixup_for_units(a, l, S, wave, bx, G * 512); \
          pg8::gemm_phase<pg8::EpiStore, pg8::MixedOrder, true, true>(lds, g, S, E, wave); } \
        xcd_barrier(bar); \
        xupd_phase(a, a.in[15] + l * D, NS_DN, l == DEPTH - 1, gw, NGW, 0); \
        if (l + 1 < DEPTH) { convert_weights(a, l + 1, scr, gw, NGW, 0); xcd_barrier(bar); } \
 } while (0)
__global__ void __launch_bounds__(512, 2) fwd_megakernel(Args a) {
    extern __shared__ __attribute__((aligned(16))) unsigned char lds_raw[];
    LAS unsigned char* lds = (LAS unsigned char*)lds_raw;
    cg::grid_group grid = cg::this_grid();
    const int wave = __builtin_amdgcn_readfirstlane((int)threadIdx.x >> 6);
    const int G = gridDim.x, bx = blockIdx.x;
    const int vcu = (G % 8 == 0) ? (bx % 8) * (G / 8) + bx / 8 : bx;
    const int gw = vcu * 8 + wave, NGW = G * 8;
    LAS float* scr = (LAS float*)(lds + wave * 16384);
    bf16* XB = (bf16*)(a.ws + WS_XB); bf16* Z = (bf16*)(a.ws + WS_Z); bf16* MIXIN = (bf16*)(a.ws + WS_MIXIN); bf16* MIX = (bf16*)(a.ws + WS_MIX); bf16* ACT = (bf16*)(a.ws + WS_ACT);
    const bf16* WIN = (const bf16*)(a.ws + WS_WIN); const bf16* WOUT = (const bf16*)(a.ws + WS_WOUT); const bf16* WUP = (const bf16*)(a.ws + WS_WUP); const bf16* WDN = (const bf16*)(a.ws + WS_WDN);

    volatile LAS unsigned* bst = (volatile LAS unsigned*)(lds + 131072);
    if (threadIdx.x < 2) bst[threadIdx.x] = 0u;
    __syncthreads();
    XcdBarrier bar = xcd_barrier_post((unsigned*)a.ws, bst); bar.wave = wave;
    if (a.ws == nullptr) grid.sync();
    convert_weights(a, 0, scr, gw, NGW, 0);
    x_prologue(a, gw, NGW, 0);
    xcd_barrier(bar);
    LAYER_BODY(0); LAYER_BODY(1); LAYER_BODY(2); LAYER_BODY(3);
}

extern "C" void kernel_launch(void* const* d_in, const int* in_sizes, int n_in, void* d_out, int out_size, void* d_ws, size_t ws_size, hipStream_t stream) {
    static int grid = 0;
    if (grid == 0) {
        if (n_in != 20 || (size_t)out_size != OUT_END || ws_size < WS_END) { fprintf(stderr, "kernel_launch: unexpected shapes (n_in %d out %d ws %zu); nothing launched\n", n_in, out_size, ws_size); grid = -1; return; }
        int dev = 0, cus = 0, per_cu = 0;
        (void)hipGetDevice(&dev);
        (void)hipDeviceGetAttribute(&cus, hipDeviceAttributeMultiprocessorCount, dev);
        (void)hipFuncSetAttribute((const void*)fwd_megakernel, hipFuncAttributeMaxDynamicSharedMemorySize, LDS_BYTES);
        (void)hipOccupancyMaxActiveBlocksPerMultiprocessor(&per_cu, (const void*)fwd_megakernel, 512, LDS_BYTES);
        if (per_cu < 1) per_cu = 1;
        grid = cus * per_cu;
        if (grid != 256) { fprintf(stderr, "kernel_launch: this kernel's phase program is laid out for 256 resident workgroups (one per CU of a 256-CU device), got %d; nothing launched\n", grid); grid = -1; return; }
    }
    if (grid < 0) return;
    if (hipMemsetAsync(d_ws, 0, 16384, stream) != hipSuccess) { fprintf(stderr, "kernel_launch: hipMemsetAsync of the barrier words failed\n"); return; }
    Args a{};
    for (int i = 0; i < 20; ++i) a.in[i] = (const float*)d_in[i];
    a.out = (float*)d_out; a.ws = (unsigned char*)d_ws;
    void* args[] = {&a};
    hipError_t e = hipLaunchCooperativeKernel((const void*)fwd_megakernel, dim3(grid), dim3(512), args, LDS_BYTES, stream);
    if (e != hipSuccess) fprintf(stderr, "cooperative launch failed: %s (grid %d)\n", hipGetErrorString(e), grid);
}
```

```cpp
#include <hip/hip_runtime.h>
#include <hip/hip_cooperative_groups.h>
#include <cstdio>
#include <cstdint>
namespace cg = cooperative_groups;

namespace pg8 {
#define PG8_LAS __attribute__((address_space(3)))
typedef unsigned short bf16_t;
typedef short bf16x8 __attribute__((ext_vector_type(8)));
typedef float f32x4 __attribute__((ext_vector_type(4)));
typedef unsigned u32x4 __attribute__((ext_vector_type(4)));
constexpr int BM = 256, BK = 64, HALF = 128, HTB = HALF * BK * 2  , STAGE_BYTES = 8 * HTB, NXCD = 8, WGM = 8;

__host__ __device__ __forceinline__ int lds_byte(int r, int c) { const int st = (r >> 4) * 2 + (c >> 5), rr = r & 15, cc = c & 31, ob = rr * 64 + cc * 2; return st * 1024 + (ob ^ (((ob >> 9) & 1) << 5)); }
__host__ __device__ __forceinline__ void stage_rc(int b, int& R, int& C) { const int st = b / 1024, sb = b % 1024, swz = sb ^ (((sb >> 9) & 1) << 5); R = (st >> 1) * 16 + swz / 64; C = (st & 1) * 32 + (swz % 64) / 2; }
__host__ __device__ __forceinline__ int perm32(int rho) { const int n = rho >> 4, i = rho & 15; return 8 * (i >> 2) + 4 * n + (i & 3); }

__device__ __forceinline__ int lane_id_asm() { int l; asm volatile("v_mbcnt_lo_u32_b32 %0, -1, 0\n\tv_mbcnt_hi_u32_b32 %0, -1, %0" : "=v"(l)); return l; }
struct Unit { int pm, pn, ks, k0, nt; };
struct Gemm { const bf16_t* A; const bf16_t* Bt; int ld; };

struct MixedOrder {
    int nN, nP, nS, ntF, ntS, nwg, G, c;
    __host__ __device__ __forceinline__ void init(int N, int ntFull, int nSplit, int G_, int c_) { nN = N / BM; nP = 64 * nN; nS = nSplit; ntF = ntFull; ntS = nSplit ? ntFull / nSplit : 0; nwg = nP + 2 * nN * nS;   G = G_; c = c_; }
    __host__ __device__ __forceinline__ bool next(int i, Unit& u) const {
        const long L = (long)i * G + c; if (L >= nwg) return false;
        int wgid = (int)L;
        if (wgid < nP) {
            { const int q = nP / NXCD, xcd = wgid % NXCD, off = wgid / NXCD; wgid = xcd * q + off; }
            const int nig = WGM * nN, gid = wgid / nig, fm = gid * WGM;
            u.pm = fm + ((wgid % nig) % WGM); u.pn = (wgid % nig) / WGM; u.ks = 0; u.k0 = 0; u.nt = ntF;
        } else {
            wgid -= nP; u.ks = wgid % nS; const int t = wgid / nS; u.pm = 64 + t / nN; u.pn = t % nN; u.k0 = u.ks * ntS; u.nt = ntS;
        }
        return true;
    }
    __device__ __forceinline__ void a_ready(const Unit&) const {}
    __device__ __forceinline__ void done(const Unit&) const {}
};

struct SampleOrder {
    int nN, ntF, c;
    __host__ __device__ __forceinline__ void init(int N, int ntFull, int c_) { nN = N / BM; ntF = ntFull; c = c_; }
    __host__ __device__ __forceinline__ bool next(int i, Unit& u) const { if (i != 0 || c >= 2 * nN) return false; u.pm = 64 + c / nN; u.pn = c % nN; u.ks = 0; u.k0 = 0; u.nt = ntF; return true; }
    __device__ __forceinline__ void a_ready(const Unit&) const {}
    __device__ __forceinline__ void done(const Unit&) const {}
};
__device__ __forceinline__ unsigned cvt_pk_bf16(float lo, float hi) { unsigned r; asm volatile("v_cvt_pk_bf16_f32 %0, %1, %2" : "=v"(r) : "v"(lo), "v"(hi)); return r; }

struct EpiStore {
    static constexpr bool PERM = true, AFTER_DRAIN = false, APERM = false;
    bf16_t* O; int ldc; float* PART; const float* rs;
    __device__ __forceinline__ void operator()(const f32x4 (&acc)[2][2][4][2], const Unit& u, int wr, int wc, int fr, int fq) const {
        const int row0 = u.pm * BM + wr * 64 + fr, col0 = u.pn * BM + wc * 32 + 8 * fq;
        if (PART != nullptr && u.pm >= 64) {
            float* base = PART + (size_t)u.ks * 512 * ldc;
#pragma unroll
            for (int ai = 0; ai < 2; ++ai)
#pragma unroll
                for (int m = 0; m < 4; ++m) { float* rowp = base + (size_t)(row0 - 16384 + ai * HALF + m * 16) * ldc + col0;
#pragma unroll
                    for (int bj = 0; bj < 2; ++bj) { *(f32x4*)(rowp + bj * HALF) = acc[ai][bj][m][0]; *(f32x4*)(rowp + bj * HALF + 4) = acc[ai][bj][m][1]; } }
            return;
        }
#pragma unroll
        for (int ai = 0; ai < 2; ++ai)
#pragma unroll
            for (int m = 0; m < 4; ++m) { bf16_t* rowp = O + (size_t)(row0 + ai * HALF + m * 16) * ldc + col0; const float r = rs ? rs[row0 + ai * HALF + m * 16] : 1.0f;
#pragma unroll
                for (int bj = 0; bj < 2; ++bj) { const f32x4 v0 = acc[ai][bj][m][0] * r, v1 = acc[ai][bj][m][1] * r;
                    u32x4 w; w.x = cvt_pk_bf16(v0[0], v0[1]); w.y = cvt_pk_bf16(v0[2], v0[3]); w.z = cvt_pk_bf16(v1[0], v1[1]); w.w = cvt_pk_bf16(v1[2], v1[3]);
                    *(u32x4*)(rowp + bj * HALF) = w; } }
    }
};

__device__ __forceinline__ float silu_f(float x) { return x * __builtin_amdgcn_rcpf(1.0f + __expf(-x)); }

struct EpiUp {
    static constexpr bool PERM = true, AFTER_DRAIN = false, APERM = true;
    bf16_t* ACT; float* HEAD; float* TAIL; const float* cw; const float* rs;
    typedef float f32x2 __attribute__((ext_vector_type(2)));
    static __device__ __forceinline__ f32x2 shr1(f32x2 v, int src4) {
        (void)src4; const float a = v.x, b = v.y;
        f32x2 r; r.x = __int_as_float(__builtin_amdgcn_update_dpp(0, __float_as_int(a), 0x121, 0xf, 0xf, false)); r.y = __int_as_float(__builtin_amdgcn_update_dpp(0, __float_as_int(b), 0x121, 0xf, 0xf, false)); return r; }
    __device__ __forceinline__ void operator()(f32x4 (&acc)[2][2][4][2], const Unit& u, int wr, int wc, int fr, int fq) const {
        { float rr[2][4];
#pragma unroll
          for (int ai = 0; ai < 2; ++ai)
#pragma unroll
              for (int m = 0; m < 4; ++m) rr[ai][m] = rs[u.pm * BM + ai * HALF + wr * 64 + 4 * fr + m];
#pragma unroll
          for (int ai = 0; ai < 2; ++ai)
#pragma unroll
              for (int m = 0; m < 4; ++m)
#pragma unroll
                  for (int bj = 0; bj < 2; ++bj) { acc[ai][bj][m][0] *= rr[ai][m]; acc[ai][bj][m][1] *= rr[ai][m]; } }
        const int chl = wc * 32 + 8 * fq, ch0 = u.pn * 128 + chl;
        const int src4 = 4 * ((16 * fq) | ((fr + 15) & 15));
        f32x2 wgk[3], wvk[3], wgn[3], wvn[3];
#pragma unroll
        for (int k = 0; k < 3; ++k) { wgk[k] = *(const f32x2*)(cw + k * 5632 + ch0); wvk[k] = *(const f32x2*)(cw + k * 5632 + 2816 + ch0); }
        unsigned pw[2][4][4];
#pragma unroll
        for (int gi = 0; gi < 4; ++gi) {
            const int n = gi >> 1, j0 = 2 * (gi & 1);
            if (gi < 3) {
#pragma unroll
                for (int k = 0; k < 3; ++k) { wgn[k] = *(const f32x2*)(cw + k * 5632 + ch0 + 2 * (gi + 1)); wvn[k] = *(const f32x2*)(cw + k * 5632 + 2816 + ch0 + 2 * (gi + 1)); }
            }
#pragma unroll
            for (int ai = 0; ai < 2; ++ai) {
                f32x2 xg[4], xv[4];
#pragma unroll
                for (int m = 0; m < 4; ++m) { xg[m] = (f32x2){acc[ai][0][m][n][j0], acc[ai][0][m][n][j0 + 1]}; xv[m] = (f32x2){acc[ai][1][m][n][j0], acc[ai][1][m][n][j0 + 1]}; }
                const f32x2 g3 = shr1(xg[3], src4), g2 = shr1(xg[2], src4), v3 = shr1(xv[3], src4), v2 = shr1(xv[2], src4);
                f32x2 cg[4], cv[4];
                cg[0] = wgk[0] * g2 + wgk[1] * g3 + wgk[2] * xg[0];        cv[0] = wvk[0] * v2 + wvk[1] * v3 + wvk[2] * xv[0];
                cg[1] = wgk[0] * g3 + wgk[1] * xg[0] + wgk[2] * xg[1];     cv[1] = wvk[0] * v3 + wvk[1] * xv[0] + wvk[2] * xv[1];
                cg[2] = wgk[0] * xg[0] + wgk[1] * xg[1] + wgk[2] * xg[2];  cv[2] = wvk[0] * xv[0] + wvk[1] * xv[1] + wvk[2] * xv[2];
                cg[3] = wgk[0] * xg[1] + wgk[1] * xg[2] + wgk[2] * xg[3];  cv[3] = wvk[0] * xv[1] + wvk[1] * xv[2] + wvk[2] * xv[3];
#pragma unroll
                for (int m = 0; m < 4; ++m) {
                    const f32x2 t = cg[m] * (-1.4426950408889634f);
                    f32x2 e; e.x = __builtin_amdgcn_exp2f(t.x); e.y = __builtin_amdgcn_exp2f(t.y);
                    const f32x2 d = e + 1.0f;
                    f32x2 s; s.x = __builtin_amdgcn_rcpf(d.x); s.y = __builtin_amdgcn_rcpf(d.y);
                    const f32x2 o = (cg[m] * s) * cv[m];
                    pw[ai][m][gi] = cvt_pk_bf16(o.x, o.y);
                }
                __builtin_amdgcn_sched_barrier(0);
            }
            if (gi < 3) {
#pragma unroll
                for (int k = 0; k < 3; ++k) { wgk[k] = wgn[k]; wvk[k] = wvn[k]; }
            }
        }
#pragma unroll
        for (int ai = 0; ai < 2; ++ai) {
            const int blk = 4 * u.pm + 2 * ai + wr;
            if (fr == 0) {
#pragma unroll
                for (int m = 0; m < 2; ++m)
#pragma unroll
                    for (int bj = 0; bj < 2; ++bj)
#pragma unroll
                        for (int n = 0; n < 2; ++n) *(f32x4*)(HEAD + ((size_t)blk * 2 + m) * 5632 + u.pn * 256 + bj * 128 + chl + 4 * n) = acc[ai][bj][m][n];
            }
            if (fr == 15) {
#pragma unroll
                for (int m = 2; m < 4; ++m)
#pragma unroll
                    for (int bj = 0; bj < 2; ++bj)
#pragma unroll
                        for (int n = 0; n < 2; ++n) *(f32x4*)(TAIL + ((size_t)blk * 2 + (m - 2)) * 5632 + u.pn * 256 + bj * 128 + chl + 4 * n) = acc[ai][bj][m][n];
            }
#pragma unroll
            for (int m = 0; m < 4; ++m) {
                if (m >= 2 || fr > 0) {
                    u32x4 w; w.x = pw[ai][m][0]; w.y = pw[ai][m][1]; w.z = pw[ai][m][2]; w.w = pw[ai][m][3];
                    *(u32x4*)(ACT + (size_t)(64 * blk + 4 * fr + m) * 2816 + ch0) = w;
                }
            }
        }
    }
};

template <class Epi, class Sched, bool ALIGN_EPI = false, bool SP2 = false>
__device__ __forceinline__ void gemm_phase(PG8_LAS unsigned char* lds, const Gemm g, const Sched& S, const Epi& E, const int wave_s) {
    const int wid = wave_s, lane = lane_id_asm(), tid = wid * 64 + lane, wr = wid >> 2, wc = wid & 3, fr = lane & 15, fq = lane >> 4;
    const int K = g.ld;
    unsigned voffA[2], voffB[2];
#pragma unroll
    for (int i = 0; i < 2; ++i) { int R, C; stage_rc(tid * 16 + i * 8192, R, C); const int Rb = Epi::PERM ? ((R & ~31) + perm32(R & 31)) : R;
        const int Ra = Epi::APERM ? ((R & ~63) + 4 * (R & 15) + ((R & 63) >> 4)) : R;
        voffA[i] = (unsigned)(Ra * K + C) * 2u; voffB[i] = (unsigned)(Rb * K + C) * 2u; }
    const size_t kstep = (size_t)(BK * 2);
    const size_t hstep = (size_t)HALF * K * 2;
    const size_t tstep = 2 * hstep;
    const unsigned ldsw = (unsigned)wid * 1024u;
    const int aoff = lds_byte(wr * 64 + fr, fq * 8), boff = lds_byte(wc * 32 + fr, fq * 8);
#define PG8_SA(b, h) (((b) * 2 + (h)) * HTB)
#define PG8_SB(b, h) ((4 + (b) * 2 + (h)) * HTB)
#define PG8_STAGE(bufoff, gbase, voff) do { _Pragma("unroll") for (int _i = 0; _i < 2; ++_i) \
        __builtin_amdgcn_global_load_lds((const unsigned*)((const char*)(gbase) + (voff)[_i]), (PG8_LAS unsigned*)(lds + (bufoff) + ldsw + _i * 8192), 16, 0, 0); } while (0)
#define PG8_LDA(dst, b, h) do { _Pragma("unroll") for (int m = 0; m < 4; ++m) _Pragma("unroll") for (int k = 0; k < 2; ++k) dst[m][k] = *(const PG8_LAS bf16x8*)(lds + PG8_SA(b, h) + aoff + m * 2048 + k * 1024); } while (0)
#define PG8_LDB(dst, b, h) do { _Pragma("unroll") for (int n = 0; n < 2; ++n) _Pragma("unroll") for (int k = 0; k < 2; ++k) dst[n][k] = *(const PG8_LAS bf16x8*)(lds + PG8_SB(b, h) + boff + n * 2048 + k * 1024); } while (0)
#define PG8_MMA(ai, bj, At, Bt) do { __builtin_amdgcn_s_setprio(1); _Pragma("unroll") for (int m = 0; m < 4; ++m) _Pragma("unroll") for (int n = 0; n < 2; ++n) _Pragma("unroll") for (int k = 0; k < 2; ++k) \
        acc[ai][bj][m][n] = __builtin_amdgcn_mfma_f32_16x16x32_bf16(Bt[n][k], At[m][k], acc[ai][bj][m][n], 0, 0, 0); __builtin_amdgcn_s_setprio(0); } while (0)
#define PG8_WAIT_V(n) asm volatile("s_waitcnt vmcnt(" #n ")" ::: "memory")
#define PG8_WAIT_L(n) asm volatile("s_waitcnt lgkmcnt(" #n ")" ::: "memory")
#define PG8_BAR __builtin_amdgcn_s_barrier()
#define PG8_SCHED __builtin_amdgcn_sched_barrier(0)
    Unit cur, nxt; int ui = 0;
    if (!S.next(0, cur)) return;
    f32x4 acc[2][2][4][2];
#pragma unroll
    for (int a = 0; a < 2; ++a)
#pragma unroll
        for (int b = 0; b < 2; ++b)
#pragma unroll
            for (int m = 0; m < 4; ++m)
#pragma unroll
                for (int n = 0; n < 2; ++n) acc[a][b][m][n] = (f32x4){0.f, 0.f, 0.f, 0.f};
    bf16x8 At[4][2], B0[2][2], B1[2][2];
    const char* cA = (const char*)g.A + (size_t)cur.pm * tstep + (size_t)cur.k0 * kstep; const char* cB = (const char*)g.Bt + (size_t)cur.pn * tstep + (size_t)cur.k0 * kstep;
    S.a_ready(cur);
    if constexpr (SP2) {
        PG8_STAGE(PG8_SB(0, 0), cB, voffB); PG8_STAGE(PG8_SB(0, 1), cB + hstep, voffB); PG8_STAGE(PG8_SA(0, 0), cA, voffA); PG8_STAGE(PG8_SA(0, 1), cA + hstep, voffA);
        if (wr == 1) PG8_BAR;
        PG8_WAIT_V(2); PG8_BAR;
        PG8_STAGE(PG8_SB(1, 0), cB + kstep, voffB); PG8_STAGE(PG8_SA(1, 0), cA + kstep, voffA); PG8_STAGE(PG8_SB(1, 1), cB + hstep + kstep, voffB);
        PG8_WAIT_V(6); PG8_BAR;
    } else {
        PG8_STAGE(PG8_SB(0, 0), cB, voffB); PG8_STAGE(PG8_SA(0, 0), cA, voffA); PG8_STAGE(PG8_SB(0, 1), cB + hstep, voffB); PG8_STAGE(PG8_SA(0, 1), cA + hstep, voffA);
        if (wr == 1) PG8_BAR;
        PG8_WAIT_V(4); PG8_BAR;
        PG8_STAGE(PG8_SB(1, 0), cB + kstep, voffB); PG8_STAGE(PG8_SA(1, 0), cA + kstep, voffA); PG8_STAGE(PG8_SB(1, 1), cB + hstep + kstep, voffB);
        PG8_WAIT_V(6); PG8_BAR;
    }
    for (;;) {
        const bool has_next = S.next(ui + 1, nxt); const int nt = cur.nt;
        const char* nA = has_next ? (const char*)g.A + (size_t)nxt.pm * tstep + (size_t)nxt.k0 * kstep : cA; const char* nB = has_next ? (const char*)g.Bt + (size_t)nxt.pn * tstep + (size_t)nxt.k0 * kstep : cB;
        for (int t = 0; t < nt; t += 2) {
            const bool last = (t == nt - 2);
            const char* a1 = cA + (size_t)(t + 1) * kstep;
            const char* a2 = last ? nA : cA + (size_t)(t + 2) * kstep; const char* b2 = last ? nB : cB + (size_t)(t + 2) * kstep;
            const char* a3 = a2 + kstep; const char* b3 = b2 + kstep;
            if (last && has_next) S.a_ready(nxt);
            if constexpr (SP2) {
            PG8_LDB(B0, 0, 0); PG8_LDB(B1, 0, 1); PG8_SCHED; PG8_LDA(At, 0, 0); PG8_STAGE(PG8_SA(1, 1), a1 + hstep, voffA);
            PG8_WAIT_V(8); PG8_WAIT_L(0); PG8_BAR; PG8_MMA(0, 0, At, B0); PG8_MMA(0, 1, At, B1); PG8_BAR; PG8_SCHED;
            PG8_LDA(At, 0, 1); PG8_STAGE(PG8_SB(0, 0), b2, voffB); PG8_STAGE(PG8_SB(0, 1), b2 + hstep, voffB); PG8_STAGE(PG8_SA(0, 0), a2, voffA);
            PG8_WAIT_V(8); PG8_WAIT_L(0); PG8_BAR; PG8_MMA(1, 0, At, B0); PG8_MMA(1, 1, At, B1); PG8_BAR; PG8_SCHED;
            PG8_LDB(B0, 1, 0); PG8_LDB(B1, 1, 1); PG8_SCHED; PG8_LDA(At, 1, 0); PG8_STAGE(PG8_SA(0, 1), a2 + hstep, voffA);
            PG8_WAIT_V(8); PG8_WAIT_L(0); PG8_BAR; PG8_MMA(0, 0, At, B0); PG8_MMA(0, 1, At, B1); PG8_BAR; PG8_SCHED;
            PG8_LDA(At, 1, 1); PG8_STAGE(PG8_SB(1, 0), b3, voffB); PG8_STAGE(PG8_SB(1, 1), b3 + hstep, voffB); PG8_STAGE(PG8_SA(1, 0), a3, voffA);
            PG8_WAIT_V(8); PG8_WAIT_L(0); PG8_BAR; PG8_MMA(1, 0, At, B0); PG8_MMA(1, 1, At, B1); PG8_BAR; PG8_SCHED;
            } else {
            PG8_LDB(B0, 0, 0); PG8_SCHED; PG8_LDA(At, 0, 0); PG8_STAGE(PG8_SA(1, 1), a1 + hstep, voffA);
            PG8_WAIT_L(8); PG8_BAR; PG8_WAIT_L(0); PG8_MMA(0, 0, At, B0); PG8_BAR; PG8_SCHED;
            PG8_LDB(B1, 0, 1); PG8_STAGE(PG8_SB(0, 0), b2, voffB);
            PG8_BAR; PG8_WAIT_L(0); PG8_MMA(0, 1, At, B1); PG8_BAR;
            PG8_LDA(At, 0, 1); PG8_STAGE(PG8_SA(0, 0), a2, voffA);
            PG8_BAR; PG8_WAIT_L(0); PG8_MMA(1, 0, At, B0); PG8_BAR; PG8_SCHED;
            PG8_STAGE(PG8_SB(0, 1), b2 + hstep, voffB);
            PG8_WAIT_V(6); PG8_BAR; PG8_MMA(1, 1, At, B1); PG8_BAR;
            PG8_LDB(B0, 1, 0); PG8_SCHED; PG8_LDA(At, 1, 0); PG8_STAGE(PG8_SA(0, 1), a2 + hstep, voffA);
            PG8_WAIT_L(8); PG8_BAR; PG8_WAIT_L(0); PG8_MMA(0, 0, At, B0); PG8_BAR; PG8_SCHED;
            PG8_LDB(B1, 1, 1); PG8_STAGE(PG8_SB(1, 0), b3, voffB);
            PG8_BAR; PG8_WAIT_L(0); PG8_MMA(0, 1, At, B1); PG8_BAR;
            PG8_LDA(At, 1, 1); PG8_STAGE(PG8_SA(1, 0), a3, voffA);
            PG8_BAR; PG8_WAIT_L(0); PG8_MMA(1, 0, At, B0); PG8_BAR; PG8_SCHED;
            PG8_STAGE(PG8_SB(1, 1), b3 + hstep, voffB);
            PG8_WAIT_V(6); PG8_BAR; PG8_MMA(1, 1, At, B1); PG8_BAR;
            }
        }
        if constexpr (ALIGN_EPI) { if (wr == 0) PG8_BAR; }
        if constexpr (!Epi::AFTER_DRAIN) { E(acc, cur, wr, wc, fr, fq); S.done(cur); }
        if (!has_next) break;
#pragma unroll
        for (int a = 0; a < 2; ++a)
#pragma unroll
            for (int b = 0; b < 2; ++b)
#pragma unroll
                for (int m = 0; m < 4; ++m)
#pragma unroll
                    for (int n = 0; n < 2; ++n) acc[a][b][m][n] = (f32x4){0.f, 0.f, 0.f, 0.f};
        cur = nxt; cA = nA; cB = nB; ++ui;
        if constexpr (ALIGN_EPI) { if (wr == 1) PG8_BAR; }
    }
    PG8_WAIT_V(0);
    if constexpr (!ALIGN_EPI) { if (wr == 0) PG8_BAR; }
    PG8_BAR;
    if constexpr (Epi::AFTER_DRAIN) { E.fused(acc, cur, wr, wc, fr, fq, lds, wid, lane); S.done(cur); }
#undef PG8_SA
#undef PG8_SB
#undef PG8_STAGE
#undef PG8_LDA
#undef PG8_LDB
#undef PG8_MMA
#undef PG8_WAIT_V
#undef PG8_WAIT_L
#undef PG8_BAR
#undef PG8_SCHED
}
}

#define LAS __attribute__((address_space(3)))
typedef unsigned short bf16;
typedef unsigned v4u __attribute__((ext_vector_type(4)));
typedef unsigned v2u __attribute__((ext_vector_type(2)));
typedef float f32x4 __attribute__((ext_vector_type(4)));
typedef short bf16x8 __attribute__((ext_vector_type(8)));

constexpr int M = 16896, MP = 16384, D = 1024, DIN = 2048, DFF = 2816, DUP = 5632, DEPTH = 4;
constexpr float EPS = 1e-6f;
constexpr int LDS_BYTES = 147456;
constexpr size_t OUT_POOL_P = (size_t)M * D, OUT_CONV_P = OUT_POOL_P + 245760, OUT_FFN_P = OUT_CONV_P + 32768,
                 OUT_POOL_S = OUT_FFN_P + 360448, OUT_CONV_S = OUT_POOL_S + 245760, OUT_FFN_S = OUT_CONV_S + 32768, OUT_END = OUT_FFN_S + 360448;
constexpr size_t MiB = 1u << 20;
constexpr size_t WS_RS = 65536;
constexpr size_t WS_WIN = 1 * MiB, WS_WOUT = 5 * MiB, WS_WUP = 7 * MiB, WS_WDN = 18 * MiB, WS_PMT = 18 * MiB + 5767168, WS_XB = 24 * MiB;
constexpr int ZLD = 2080;
constexpr size_t WS_Z = 57 * MiB, WS_MIXIN = 125 * MiB, WS_MIX = 158 * MiB, WS_PART = 191 * MiB;
constexpr int NS_OUT = 8, NS_DN = 11;
constexpr size_t WS_ACT = 57 * MiB, WS_HEAD = 222 * MiB, WS_TAIL = 234 * MiB, WS_END = 246 * MiB;
static_assert(WS_Z + (size_t)M * ZLD * 2 <= WS_MIXIN && WS_MIXIN + (size_t)M * D * 2 <= WS_MIX && WS_MIX + (size_t)M * D * 2 <= WS_PART && WS_PART + (size_t)11 * 512 * D * 4 <= WS_HEAD, "ws map 2");
static_assert(WS_PMT + 4 * 16384 * 2 <= WS_XB && WS_ACT + (size_t)M * DFF * 2 <= WS_MIX && WS_HEAD + 264 * 2 * 5632 * 4 <= WS_TAIL && WS_TAIL + 264 * 2 * 5632 * 4 <= WS_END, "ws map");

struct Args { const float* in[20]; float* out; unsigned char* ws; };

#define LDS_WAIT() asm volatile("s_waitcnt lgkmcnt(0)" ::: "memory")
__device__ __forceinline__ unsigned f2bf(float f) { unsigned u = __builtin_bit_cast(unsigned, f); return (u + 0x7fffu + ((u >> 16) & 1u)) >> 16; }
__device__ __forceinline__ unsigned pk2(float lo, float hi) { unsigned r; asm("v_cvt_pk_bf16_f32 %0, %1, %2" : "=v"(r) : "v"(lo), "v"(hi)); return r; }
__device__ __forceinline__ float bflo(unsigned w) { return __uint_as_float(w << 16); }
__device__ __forceinline__ float bfhi(unsigned w) { return __uint_as_float(w & 0xffff0000u); }
__device__ __forceinline__ float dpp_f(float v, const int ctrl_unused) { return v; }
__device__ __forceinline__ float wave_sum(float v) {
    v += __int_as_float(__builtin_amdgcn_update_dpp(0, __float_as_int(v), 0xB1, 0xf, 0xf, false));
    v += __int_as_float(__builtin_amdgcn_update_dpp(0, __float_as_int(v), 0x4E, 0xf, 0xf, false));
    v += __int_as_float(__builtin_amdgcn_update_dpp(0, __float_as_int(v), 0x141, 0xf, 0xf, false));
    v += __int_as_float(__builtin_amdgcn_update_dpp(0, __float_as_int(v), 0x140, 0xf, 0xf, false));
    const int iv = __float_as_int(v);
    return (__int_as_float(__builtin_amdgcn_readlane(iv, 0)) + __int_as_float(__builtin_amdgcn_readlane(iv, 16))) + (__int_as_float(__builtin_amdgcn_readlane(iv, 32)) + __int_as_float(__builtin_amdgcn_readlane(iv, 48)));
}
__device__ __forceinline__ float dot4(f32x4 a) { return (a[0] * a[0] + a[1] * a[1]) + (a[2] * a[2] + a[3] * a[3]); }

__device__ __forceinline__ void transpose_item(const float* W, int K, int N, const float* gain_k0, bf16* WT, int mode, LAS float* scr, int item, int lane) {
    const int nblk = N / 32, kb = item / nblk, nb = item % nblk, k0 = 64 * kb, n0 = 32 * nb;
    { f32x4 v[8]; const int kr = lane >> 3, cc = 4 * (lane & 7);
#pragma unroll
      for (int i = 0; i < 8; ++i) v[i] = *(const f32x4*)(W + (size_t)(k0 + 8 * i + kr) * N + n0 + cc);
#pragma unroll
      for (int i = 0; i < 8; ++i) { const int kk = 8 * i + kr; const float g = gain_k0 ? gain_k0[kk] : 1.0f; LAS float* d = scr + kk * 33 + cc; d[0] = v[i][0] * g; d[1] = v[i][1] * g; d[2] = v[i][2] * g; d[3] = v[i][3] * g; } }
    LDS_WAIT(); asm volatile("" ::: "memory");
    int drow = n0;
    if (mode == 1) drow = n0 < DFF ? 256 * (n0 >> 7) + (n0 & 127) : 256 * ((n0 - DFF) >> 7) + 128 + ((n0 - DFF) & 127);
    const int c = lane & 7;
#pragma unroll
    for (int j = 0; j < 4; ++j) { const int n = (lane >> 3) + 8 * j; const LAS float* s = scr + (8 * c) * 33 + n;
        v4u o; o.x = pk2(s[0 * 33], s[1 * 33]); o.y = pk2(s[2 * 33], s[3 * 33]); o.z = pk2(s[4 * 33], s[5 * 33]); o.w = pk2(s[6 * 33], s[7 * 33]);
        *(v4u*)(WT + (size_t)(drow + n) * K + k0 + 8 * c) = o; }
    LDS_WAIT(); asm volatile("" ::: "memory");
}

__device__ __forceinline__ void convert_weights(const Args& a, int l, LAS float* scr, int gw, int NGW, int lane_) {
    const int lane = pg8::lane_id_asm(); (void)lane_;
    constexpr int I_IN = 16 * 64, I_OUT = 16 * 32, I_UP = 16 * 176, I_DN = 44 * 32, I_PM = 4 * 8, NITEMS = I_IN + I_OUT + I_UP + I_DN + I_PM;
    bf16* WIN = (bf16*)(a.ws + WS_WIN); bf16* WOUT = (bf16*)(a.ws + WS_WOUT); bf16* WUP = (bf16*)(a.ws + WS_WUP); bf16* WDN = (bf16*)(a.ws + WS_WDN); bf16* PMT = (bf16*)(a.ws + WS_PMT);
    for (int it = gw; it < NITEMS; it += NGW) {
        int r = it;
        if (r < I_IN) { const int k0 = 64 * (r / 64); transpose_item(a.in[5] + (size_t)l * D * DIN, D, DIN, a.in[12] + l * D + k0, WIN, 0, scr, r, lane); continue; } r -= I_IN;
        if (r < I_OUT) { const int k0 = 64 * (r / 32); const float* gn = k0 < 512 ? a.in[9] + l * 512 + k0 : a.in[10] + l * 512 + (k0 - 512);
            transpose_item(a.in[11] + (size_t)l * D * D, D, D, gn, WOUT, 0, scr, r, lane); continue; } r -= I_OUT;
        if (r < I_UP) { const int k0 = 64 * (r / 176); transpose_item(a.in[16] + (size_t)l * D * DUP, D, DUP, a.in[14] + l * D + k0, WUP, 1, scr, r, lane); continue; } r -= I_UP;
        if (r < I_DN) { transpose_item(a.in[18] + (size_t)l * DFF * D, DFF, D, nullptr, WDN, 0, scr, r, lane); continue; } r -= I_DN;
        const int g = r >> 3; transpose_item(a.in[6] + (size_t)(l * 4 + g) * 16384, 128, 128, nullptr, PMT + (size_t)g * 16384, 0, scr, r & 7, lane);
    }
}

__device__ __forceinline__ void x_prologue(const Args& a, int gw, int NGW, int lane_) {
    const int lane = pg8::lane_id_asm(); (void)lane_;
    bf16* XB = (bf16*)(a.ws + WS_XB); float* RS = (float*)(a.ws + WS_RS);
    for (int mb = gw; mb < M; mb += 2 * NGW) {
        f32x4 x[2][4];
#pragma unroll
        for (int r = 0; r < 2; ++r) { const int m = mb + r * NGW;
            if (m < M) { const float* src = m < MP ? a.in[0] + (size_t)m * D : a.in[1] + (size_t)(m - MP) * D;
#pragma unroll
                for (int j = 0; j < 2; ++j) { x[r][2 * j] = *(const f32x4*)(src + 8 * lane + 512 * j); x[r][2 * j + 1] = *(const f32x4*)(src + 8 * lane + 512 * j + 4); } } }
#pragma unroll
        for (int r = 0; r < 2; ++r) { const int m = mb + r * NGW;
            if (m < M) { float ss = 0.f;
#pragma unroll
                for (int j = 0; j < 4; ++j) ss += dot4(x[r][j]);
                const float rs = rsqrtf(wave_sum(ss) * (1.0f / D) + EPS);
                if (lane == 0) RS[m] = rs;
#pragma unroll
                for (int j = 0; j < 2; ++j) { v4u o; o.x = pk2(x[r][2 * j][0], x[r][2 * j][1]); o.y = pk2(x[r][2 * j][2], x[r][2 * j][3]); o.z = pk2(x[r][2 * j + 1][0], x[r][2 * j + 1][1]); o.w = pk2(x[r][2 * j + 1][2], x[r][2 * j + 1][3]);
                    *(v4u*)(XB + (size_t)m * D + 8 * lane + 512 * j) = o; } } }
    }
}

__device__ __forceinline__ void unpack8(v4u q, float (&f)[8]) { f[0] = bflo(q.x); f[1] = bfhi(q.x); f[2] = bflo(q.y); f[3] = bfhi(q.y); f[4] = bflo(q.z); f[5] = bfhi(q.z); f[6] = bflo(q.w); f[7] = bfhi(q.w); }

__device__ __forceinline__ void add8(float (&s)[8], v4u q) { s[0] += bflo(q.x); s[1] += bfhi(q.x); s[2] += bflo(q.y); s[3] += bfhi(q.y); s[4] += bflo(q.z); s[5] += bfhi(q.z); s[6] += bflo(q.w); s[7] += bfhi(q.w); }
__device__ __forceinline__ void sub8(float (&s)[8], v4u q) { s[0] -= bflo(q.x); s[1] -= bfhi(q.x); s[2] -= bflo(q.y); s[3] -= bfhi(q.y); s[4] -= bflo(q.z); s[5] -= bfhi(q.z); s[6] -= bflo(q.w); s[7] -= bfhi(q.w); }
__device__ __forceinline__ v4u pack_pool(const float (&s)[8], float inv, v4u qc) {
    v4u p; p.x = pk2(s[0] * inv - bflo(qc.x), s[1] * inv - bfhi(qc.x)); p.y = pk2(s[2] * inv - bflo(qc.y), s[3] * inv - bfhi(qc.y));
    p.z = pk2(s[4] * inv - bflo(qc.z), s[5] * inv - bfhi(qc.z)); p.w = pk2(s[6] * inv - bflo(qc.w), s[7] * inv - bfhi(qc.w)); return p; }
template <int W>
__device__ __forceinline__ void pool_rows(const bf16* Z, int seqrow0, int tb, int cg, bool sample, v4u (&pool)[4], v4u (&cur)[4]) {
    constexpr int R = W + 3;
    v4u q[R];
#pragma unroll
    for (int r = 0; r < R; ++r) { const int tr = tb - (W - 1) + r; q[r] = *(const v4u*)(Z + (size_t)(seqrow0 + (tr >= 0 ? tr : 0)) * ZLD + cg); if (tr < 0) q[r] = (v4u){0u, 0u, 0u, 0u}; }
    float s[8];
#pragma unroll
    for (int i = 0; i < 8; ++i) s[i] = 0.f;
#pragma unroll
    for (int r = 0; r < W; ++r) add8(s, q[r]);
#pragma unroll
    for (int i = 0; i < 4; ++i) {
        if (i > 0) { add8(s, q[W - 1 + i]); sub8(s, q[i - 1]); }
        const int t = tb + i; const int cnt = sample ? W : (t + 1 < W ? t + 1 : W);
        cur[i] = q[W - 1 + i]; pool[i] = pack_pool(s, 1.0f / (float)cnt, cur[i]);
    }
}
__device__ __forceinline__ void pool_rows_state(const bf16* Z, const float* sp, int seqrow0, int tb, int cg, int W, v4u (&pool)[4], v4u (&cur)[4]) {
#pragma unroll
    for (int i = 0; i < 4; ++i) {
        const int t = tb + i; float s[8];
#pragma unroll
        for (int k = 0; k < 8; ++k) s[k] = 0.f;
        for (int j = 0; j < W; ++j) { const int tr = t - j;
            if (tr >= 0) add8(s, *(const v4u*)(Z + (size_t)(seqrow0 + tr) * ZLD + cg));
            else { const float* p = sp + (size_t)(15 + tr) * 512 + cg; const f32x4 a0 = *(const f32x4*)p, a1 = *(const f32x4*)(p + 4);
                s[0] += a0[0]; s[1] += a0[1]; s[2] += a0[2]; s[3] += a0[3]; s[4] += a1[0]; s[5] += a1[1]; s[6] += a1[2]; s[7] += a1[3]; } }
        cur[i] = *(const v4u*)(Z + (size_t)(seqrow0 + t) * ZLD + cg); pool[i] = pack_pool(s, 1.0f / (float)W, cur[i]);
    }
}

__device__ __forceinline__ void mixer_phase(const Args& a, int l, int it0, int itn, int its, int lane_, LAS unsigned char* wlds  ) {
    const int lane = pg8::lane_id_asm(); (void)lane_;
    const bf16* Z = (const bf16*)(a.ws + WS_Z); bf16* MIXIN = (bf16*)(a.ws + WS_MIXIN); const bf16* PMT = (const bf16*)(a.ws + WS_PMT);
    const float* state_pool = a.in[2]; const float* state_conv = a.in[3];
    const float* pool_scale = a.in[7] + l * 512; const float* conv_w = a.in[8] + l * 3 * 512;
    const int fr = lane & 15, fq = lane >> 4;
    for (int it = it0; it < itn; it += its) {
        const int tb = it / 5, task = it - tb * 5;
        const int m0 = tb * 16; const bool sample = m0 >= MP;
        int seq, t0, T; if (!sample) { seq = m0 >> 11; t0 = m0 & 2047; T = 2048; } else { seq = (m0 - MP) >> 6; t0 = (m0 - MP) & 63; T = 64; }
        const int seqrow0 = m0 - t0;
        if (task < 4) {
            const int g = task;
            const bool last = (t0 + 16 == T);
            float* out_pool = a.out + (sample ? OUT_POOL_S : OUT_POOL_P) + (size_t)(l * 8 + seq) * 15 * 512;
            { const int cg = g * 128 + 8 * fr, tbq = t0 + 4 * fq;
              v4u pool[4], cur[4];
              if (sample && t0 == 0) pool_rows_state(Z, state_pool + (size_t)(l * 8 + seq) * 15 * 512, seqrow0, tbq, cg, 2 << g, pool, cur);
              else if (g == 0) pool_rows<2>(Z, seqrow0, tbq, cg, sample, pool, cur);
              else if (g == 1) pool_rows<4>(Z, seqrow0, tbq, cg, sample, pool, cur);
              else if (g == 2) pool_rows<8>(Z, seqrow0, tbq, cg, sample, pool, cur);
              else pool_rows<16>(Z, seqrow0, tbq, cg, sample, pool, cur);
#pragma unroll
              for (int i = 0; i < 4; ++i) {
                  *(LAS v4u*)(wlds + (4 * fq + i) * 272 + 16 * fr) = pool[i];
                  const int ti = 4 * fq + i;
                  if (last && ti >= 1) { float* op = out_pool + (size_t)(ti - 1) * 512 + cg;
                      *(f32x4*)op = (f32x4){bflo(cur[i].x), bfhi(cur[i].x), bflo(cur[i].y), bfhi(cur[i].y)}; *(f32x4*)(op + 4) = (f32x4){bflo(cur[i].z), bfhi(cur[i].z), bflo(cur[i].w), bfhi(cur[i].w)}; }
              } }
            LDS_WAIT(); asm volatile("" ::: "memory");
            bf16x8 pf[4];
#pragma unroll
            for (int ks = 0; ks < 4; ++ks) pf[ks] = *(const LAS bf16x8*)(wlds + fr * 272 + ks * 64 + fq * 16);
            f32x4 ya[8]; float ss = 0.f;
#pragma unroll
            for (int n = 0; n < 8; ++n) {
                f32x4 acc = {0.f, 0.f, 0.f, 0.f};
                const int drow = 32 * (n >> 1) + 8 * (fr >> 2) + 4 * (n & 1) + (fr & 3);
#pragma unroll
                for (int ks = 0; ks < 4; ++ks) {
                    const bf16x8 wf = *(const bf16x8*)(PMT + (size_t)g * 16384 + (size_t)drow * 128 + ks * 32 + fq * 8);
                    acc = __builtin_amdgcn_mfma_f32_16x16x32_bf16(wf, pf[ks], acc, 0, 0, 0);
                }
                const f32x4 sc = *(const f32x4*)(pool_scale + g * 128 + 32 * (n >> 1) + 8 * fq + 4 * (n & 1));
                acc = acc * sc; ya[n] = acc; ss += dot4(acc);
            }
            ss += __shfl_xor(ss, 16); ss += __shfl_xor(ss, 32);
            const float rs = rsqrtf(ss * (1.0f / 128.0f) + EPS);
#pragma unroll
            for (int np = 0; np < 4; ++np) { v4u o; o.x = pk2(ya[2 * np][0] * rs, ya[2 * np][1] * rs); o.y = pk2(ya[2 * np][2] * rs, ya[2 * np][3] * rs); o.z = pk2(ya[2 * np + 1][0] * rs, ya[2 * np + 1][1] * rs); o.w = pk2(ya[2 * np + 1][2] * rs, ya[2 * np + 1][3] * rs);
                *(v4u*)(MIXIN + (size_t)(m0 + fr) * D + g * 128 + 32 * np + 8 * fq) = o; }
            LDS_WAIT(); asm volatile("" ::: "memory");
        } else {
            const int c0 = lane * 8;
            float* out_conv = a.out + (sample ? OUT_CONV_S : OUT_CONV_P) + (size_t)(l * 8 + seq) * 2 * 512;
            float w0[8], w1[8], w2[8], cm2[8], cm1[8];
            { const f32x4 q0 = *(const f32x4*)(conv_w + c0), q1 = *(const f32x4*)(conv_w + c0 + 4); w0[0] = q0[0]; w0[1] = q0[1]; w0[2] = q0[2]; w0[3] = q0[3]; w0[4] = q1[0]; w0[5] = q1[1]; w0[6] = q1[2]; w0[7] = q1[3]; }
            { const f32x4 q0 = *(const f32x4*)(conv_w + 512 + c0), q1 = *(const f32x4*)(conv_w + 512 + c0 + 4); w1[0] = q0[0]; w1[1] = q0[1]; w1[2] = q0[2]; w1[3] = q0[3]; w1[4] = q1[0]; w1[5] = q1[1]; w1[6] = q1[2]; w1[7] = q1[3]; }
            { const f32x4 q0 = *(const f32x4*)(conv_w + 1024 + c0), q1 = *(const f32x4*)(conv_w + 1024 + c0 + 4); w2[0] = q0[0]; w2[1] = q0[1]; w2[2] = q0[2]; w2[3] = q0[3]; w2[4] = q1[0]; w2[5] = q1[1]; w2[6] = q1[2]; w2[7] = q1[3]; }
            if (t0 > 0) {
                float gc[8], u[8];
                unpack8(*(const v4u*)(Z + (size_t)(m0 - 2) * ZLD + 1024 + c0), gc); unpack8(*(const v4u*)(Z + (size_t)(m0 - 2) * ZLD + 1536 + c0), u);
#pragma unroll
                for (int i = 0; i < 8; ++i) cm2[i] = gc[i] * u[i];
                unpack8(*(const v4u*)(Z + (size_t)(m0 - 1) * ZLD + 1024 + c0), gc); unpack8(*(const v4u*)(Z + (size_t)(m0 - 1) * ZLD + 1536 + c0), u);
#pragma unroll
                for (int i = 0; i < 8; ++i) cm1[i] = gc[i] * u[i];
            } else if (sample) {
                const float* sp = state_conv + (size_t)(l * 8 + seq) * 2 * 512 + c0;
                const f32x4 a0 = *(const f32x4*)sp, a1 = *(const f32x4*)(sp + 4), b0 = *(const f32x4*)(sp + 512), b1 = *(const f32x4*)(sp + 516);
                cm2[0] = a0[0]; cm2[1] = a0[1]; cm2[2] = a0[2]; cm2[3] = a0[3]; cm2[4] = a1[0]; cm2[5] = a1[1]; cm2[6] = a1[2]; cm2[7] = a1[3];
                cm1[0] = b0[0]; cm1[1] = b0[1]; cm1[2] = b0[2]; cm1[3] = b0[3]; cm1[4] = b1[0]; cm1[5] = b1[1]; cm1[6] = b1[2]; cm1[7] = b1[3];
            } else {
#pragma unroll
                for (int i = 0; i < 8; ++i) { cm2[i] = 0.f; cm1[i] = 0.f; }
            }
#pragma unroll 1
            for (int ib = 0; ib < 16; ib += 8) {
                v4u qb[8], qc[8], qu[8];
#pragma unroll
                for (int ii = 0; ii < 8; ++ii) { const size_t row = (size_t)(m0 + ib + ii); qb[ii] = *(const v4u*)(Z + row * ZLD + 512 + c0); qc[ii] = *(const v4u*)(Z + row * ZLD + 1024 + c0); qu[ii] = *(const v4u*)(Z + row * ZLD + 1536 + c0); }
#pragma unroll
                for (int ii = 0; ii < 8; ++ii) {
                    const int i = ib + ii, t = t0 + i; const size_t row = (size_t)(m0 + i);
                    float gb[8], gc[8], u[8], cu[8], yb[8];
                    unpack8(qb[ii], gb); unpack8(qc[ii], gc); unpack8(qu[ii], u);
                    float ss = 0.f;
#pragma unroll
                    for (int k = 0; k < 8; ++k) { cu[k] = gc[k] * u[k]; const float co = w0[k] * cm2[k] + w1[k] * cm1[k] + w2[k] * cu[k]; yb[k] = gb[k] * co; ss += yb[k] * yb[k]; }
                    ss += __int_as_float(__builtin_amdgcn_update_dpp(0, __float_as_int(ss), 0xB1, 0xf, 0xf, false));
                    ss += __int_as_float(__builtin_amdgcn_update_dpp(0, __float_as_int(ss), 0x4E, 0xf, 0xf, false));
                    ss += __int_as_float(__builtin_amdgcn_update_dpp(0, __float_as_int(ss), 0x141, 0xf, 0xf, false));
                    const float rs = rsqrtf(ss * (1.0f / 64.0f) + EPS);
                    v4u o; o.x = pk2(yb[0] * rs, yb[1] * rs); o.y = pk2(yb[2] * rs, yb[3] * rs); o.z = pk2(yb[4] * rs, yb[5] * rs); o.w = pk2(yb[6] * rs, yb[7] * rs);
                    *(v4u*)(MIXIN + row * D + 512 + c0) = o;
                    if (t >= T - 2) { float* op = out_conv + (size_t)(t - (T - 2)) * 512 + c0; *(f32x4*)op = (f32x4){cu[0], cu[1], cu[2], cu[3]}; *(f32x4*)(op + 4) = (f32x4){cu[4], cu[5], cu[6], cu[7]}; }
#pragma unroll
                    for (int k = 0; k < 8; ++k) { cm2[k] = cm1[k]; cm1[k] = cu[k]; }
                }
            }
        }
    }
}

__device__ __forceinline__ void xupd_phase(const Args& a, const float* gpost, int nparts, bool final_, int gw, int NGW, int lane_, int m_lo = 0) {
    const int lane = pg8::lane_id_asm(); (void)lane_;
    const bf16* P = (const bf16*)(a.ws + WS_MIX); const float* PART = (const float*)(a.ws + WS_PART); bf16* XB = (bf16*)(a.ws + WS_XB); float* RS = (float*)(a.ws + WS_RS); const float* gfin = a.in[19];
    for (int mb = m_lo + gw; mb < M; mb += 2 * NGW) {
        float x[2][16], mx[2][16]; float ss[2] = {0.f, 0.f};
#pragma unroll
        for (int r = 0; r < 2; ++r) {
            const int m = mb + r * NGW;
            if (m < M) {
#pragma unroll
                for (int j = 0; j < 2; ++j) { float f[8]; unpack8(*(const v4u*)(XB + (size_t)m * D + 8 * lane + 512 * j), f);
#pragma unroll
                    for (int i = 0; i < 8; ++i) x[r][8 * j + i] = f[i]; }
                if (m < MP) {
#pragma unroll
                    for (int j = 0; j < 2; ++j) { float f[8]; unpack8(*(const v4u*)(P + (size_t)m * D + 8 * lane + 512 * j), f);
#pragma unroll
                        for (int i = 0; i < 8; ++i) mx[r][8 * j + i] = f[i]; }
                } else {
#pragma unroll
                    for (int i = 0; i < 16; ++i) mx[r][i] = 0.f;
                    for (int k0 = 0; k0 < nparts; k0 += 4) {
                        f32x4 pq[4][4];
#pragma unroll
                        for (int kk = 0; kk < 4; ++kk)
#pragma unroll
                            for (int j = 0; j < 2; ++j) { const int k = (k0 + kk < nparts) ? k0 + kk : k0; const float* pp = PART + ((size_t)k * 512 + (m - MP)) * D + 8 * lane + 512 * j; pq[kk][2 * j] = *(const f32x4*)pp; pq[kk][2 * j + 1] = *(const f32x4*)(pp + 4); }
#pragma unroll
                        for (int kk = 0; kk < 4; ++kk) { const float w = (k0 + kk < nparts) ? 1.0f : 0.0f;
#pragma unroll
                            for (int j = 0; j < 2; ++j)
#pragma unroll
                                for (int i = 0; i < 4; ++i) { mx[r][8 * j + i] += w * pq[kk][2 * j][i]; mx[r][8 * j + 4 + i] += w * pq[kk][2 * j + 1][i]; } }
                    }
                }
#pragma unroll
                for (int i = 0; i < 16; ++i) ss[r] += mx[r][i] * mx[r][i];
            }
        }
#pragma unroll
        for (int r = 0; r < 2; ++r) {
            const int m = mb + r * NGW;
            if (m < M) {
                const float rs = rsqrtf(wave_sum(ss[r]) * (1.0f / D) + EPS);
                float ss2 = 0.f;
#pragma unroll
                for (int j = 0; j < 2; ++j) { const float* gp = gpost + 8 * lane + 512 * j; const f32x4 g0 = *(const f32x4*)gp, g1 = *(const f32x4*)(gp + 4);
#pragma unroll
                    for (int i = 0; i < 4; ++i) { x[r][8 * j + i] += mx[r][8 * j + i] * rs * g0[i]; x[r][8 * j + 4 + i] += mx[r][8 * j + 4 + i] * rs * g1[i]; } }
#pragma unroll
                for (int i = 0; i < 16; ++i) ss2 += x[r][i] * x[r][i];
                const float rs2 = rsqrtf(wave_sum(ss2) * (1.0f / D) + EPS);
                if (final_) {
#pragma unroll
                    for (int j = 0; j < 2; ++j) { const float* gp = gfin + 8 * lane + 512 * j; const f32x4 g0 = *(const f32x4*)gp, g1 = *(const f32x4*)(gp + 4); float* yo = a.out + (size_t)m * D + 8 * lane + 512 * j;
                        *(f32x4*)yo = (f32x4){x[r][8 * j + 0] * rs2 * g0[0], x[r][8 * j + 1] * rs2 * g0[1], x[r][8 * j + 2] * rs2 * g0[2], x[r][8 * j + 3] * rs2 * g0[3]};
                        *(f32x4*)(yo + 4) = (f32x4){x[r][8 * j + 4] * rs2 * g1[0], x[r][8 * j + 5] * rs2 * g1[1], x[r][8 * j + 6] * rs2 * g1[2], x[r][8 * j + 7] * rs2 * g1[3]}; }
                } else {
#pragma unroll
                    for (int j = 0; j < 2; ++j) { v4u o; o.x = pk2(x[r][8 * j + 0], x[r][8 * j + 1]); o.y = pk2(x[r][8 * j + 2], x[r][8 * j + 3]); o.z = pk2(x[r][8 * j + 4], x[r][8 * j + 5]); o.w = pk2(x[r][8 * j + 6], x[r][8 * j + 7]);
                        *(v4u*)(XB + (size_t)m * D + 8 * lane + 512 * j) = o; }
                    if (lane == 0) RS[m] = rs2;
                }
            }
        }
    }
}

__device__ __forceinline__ void fixup_block(const Args& a, int l, int blk, int c4) {
    const float* HEAD = (const float*)(a.ws + WS_HEAD); const float* TAIL = (const float*)(a.ws + WS_TAIL); bf16* ACT = (bf16*)(a.ws + WS_ACT);
    const float* cw = a.in[17] + (size_t)l * 3 * DUP; const float* state_ffn = a.in[4];
    const int pg = 256 * (c4 >> 7) + (c4 & 127), pv = pg + 128;
    const bool sample = blk >= 256, seqstart = sample || (blk & 31) == 0;
    f32x4 g2 = {0.f, 0.f, 0.f, 0.f}, g1 = g2, v2 = g2, v1 = g2;
    if (!seqstart) { const float* tp = TAIL + (size_t)(blk - 1) * 2 * DUP; g2 = *(const f32x4*)(tp + pg); g1 = *(const f32x4*)(tp + DUP + pg); v2 = *(const f32x4*)(tp + pv); v1 = *(const f32x4*)(tp + DUP + pv); }
    else if (sample) { const float* sp = state_ffn + (size_t)(l * 8 + (blk - 256)) * 2 * DUP; g2 = *(const f32x4*)(sp + c4); g1 = *(const f32x4*)(sp + DUP + c4); v2 = *(const f32x4*)(sp + DFF + c4); v1 = *(const f32x4*)(sp + DUP + DFF + c4); }
    const float* hp = HEAD + (size_t)blk * 2 * DUP;
    const f32x4 h0g = *(const f32x4*)(hp + pg), h1g = *(const f32x4*)(hp + DUP + pg), h0v = *(const f32x4*)(hp + pv), h1v = *(const f32x4*)(hp + DUP + pv);
    const f32x4 w0g = *(const f32x4*)(cw + c4), w1g = *(const f32x4*)(cw + DUP + c4), w2g = *(const f32x4*)(cw + 2 * DUP + c4);
    const f32x4 w0v = *(const f32x4*)(cw + DFF + c4), w1v = *(const f32x4*)(cw + DUP + DFF + c4), w2v = *(const f32x4*)(cw + 2 * DUP + DFF + c4);
    const f32x4 cg0 = w0g * g2 + w1g * g1 + w2g * h0g, cv0 = w0v * v2 + w1v * v1 + w2v * h0v;
    const f32x4 cg1 = w0g * g1 + w1g * h0g + w2g * h1g, cv1 = w0v * v1 + w1v * h0v + w2v * h1v;
    v2u o0, o1;
    o0.x = pk2(pg8::silu_f(cg0[0]) * cv0[0], pg8::silu_f(cg0[1]) * cv0[1]); o0.y = pk2(pg8::silu_f(cg0[2]) * cv0[2], pg8::silu_f(cg0[3]) * cv0[3]);
    o1.x = pk2(pg8::silu_f(cg1[0]) * cv1[0], pg8::silu_f(cg1[1]) * cv1[1]); o1.y = pk2(pg8::silu_f(cg1[2]) * cv1[2], pg8::silu_f(cg1[3]) * cv1[3]);
    *(v2u*)(ACT + (size_t)(64 * blk) * DFF + c4) = o0; *(v2u*)(ACT + (size_t)(64 * blk + 1) * DFF + c4) = o1;
}
template <class Sched>
__device__ __forceinline__ void fixup_for_units(const Args& a, int l, const Sched& S, int tid_, int gtid_, int NT) {
    const int tid = tid_ * 64 + pg8::lane_id_asm(), gtid = gtid_ * 512 + tid;
    pg8::Unit u; int prev = -1;
    for (int i = 0; S.next(i, u); ++i) {
        if (u.pm == prev) continue;
        prev = u.pm;
        for (int it = tid; it < 4 * 704; it += 512) { const int b = it / 704; fixup_block(a, l, 4 * u.pm + b, (it - b * 704) * 4); }
    }
    const float* TAIL = (const float*)(a.ws + WS_TAIL);
    for (int it = gtid; it < 16 * 2 * 1408; it += NT) {
        const int sq = it / 2816, r = it - sq * 2816, i = r / 1408, c4 = (r - i * 1408) * 4;
        const int blk = sq < 8 ? 32 * sq + 31 : 256 + (sq - 8);
        const int pc = c4 < DFF ? 256 * (c4 >> 7) + (c4 & 127) : 256 * ((c4 - DFF) >> 7) + 128 + ((c4 - DFF) & 127);
        const f32x4 v = *(const f32x4*)(TAIL + ((size_t)blk * 2 + i) * DUP + pc);
        *(f32x4*)(a.out + (sq < 8 ? OUT_FFN_P : OUT_FFN_S) + ((size_t)(l * 8 + (sq & 7)) * 2 + i) * DUP + c4) = v;
    }
    asm volatile("s_waitcnt vmcnt(0)" ::: "memory");
    __syncthreads();
    __builtin_amdgcn_fence(__ATOMIC_ACQUIRE, "agent");
}

#define XB_TMO      128
#define XB_XCNT(j)  (256  + 64 * (j))
#define XB_XSUB(j)  (1280 + 64 * (j))
#define XB_XGEN(j)  (2304 + 64 * (j))
#define XB_TOP      3328
#define XB_TOPGEN   3392
#define XCD_BAR_WORDS 3456
#define XB_SPIN_CAP (1u << 18)

__device__ __forceinline__ unsigned xb_ld(unsigned* p)              { return __hip_atomic_load(p, __ATOMIC_RELAXED, __HIP_MEMORY_SCOPE_AGENT); }
__device__ __forceinline__ unsigned xb_add(unsigned* p, unsigned v) { return __hip_atomic_fetch_add(p, v, __ATOMIC_RELAXED, __HIP_MEMORY_SCOPE_AGENT); }
__device__ __forceinline__ unsigned xb_xcc_id() { return (unsigned)__builtin_amdgcn_s_getreg((3 << 11) | 20) & 0xFu; }
#define XB_SPIN(cond, bar) do { unsigned _sp = 0; while (cond) { __builtin_amdgcn_s_sleep(1); \
    if ((++_sp & 255u) == 0u) { if (xb_ld(&(bar)[XB_TMO])) break; if (_sp > XB_SPIN_CAP) { atomicAdd(&(bar)[XB_TMO], 1u); break; } } } } while (0)

struct XcdBarrier {
    unsigned* bar; unsigned x; int wave;
    volatile LAS unsigned* st;
};

__device__ __forceinline__ XcdBarrier xcd_barrier_post(unsigned* bar, volatile LAS unsigned* st) {
    XcdBarrier b; b.bar = bar; b.x = xb_xcc_id(); b.st = st;
    if (__builtin_amdgcn_readfirstlane((int)threadIdx.x >> 6) == 0 && pg8::lane_id_asm() == 0) (void)xb_add(&bar[XB_XCNT(b.x)], 1u);
    return b;
}
__device__ __forceinline__ void xcd_barrier_complete(unsigned* bar, unsigned x, unsigned& nloc, unsigned& nx) {
    const unsigned G = gridDim.x * gridDim.y * gridDim.z;
    unsigned sum, cnt, mine, sp = 0u;
    for (;;) {
        sum = 0u; cnt = 0u; mine = 0u;
#pragma unroll
        for (unsigned j = 0; j < 16; ++j) { const unsigned c = xb_ld(&bar[XB_XCNT(j)]); sum += c; cnt += (c > 0u) ? 1u : 0u; mine = (j == x) ? c : mine; }
        if (sum == G) break;
        __builtin_amdgcn_s_sleep(1);
        if ((++sp & 255u) == 0u) { if (xb_ld(&bar[XB_TMO])) break; if (sp > XB_SPIN_CAP) { atomicAdd(&bar[XB_TMO], 1u); break; } }
    }
    nloc = mine > 0u ? mine : 1u; nx = cnt > 0u ? cnt : 1u;
}

__device__ __forceinline__ void xcd_barrier(const XcdBarrier& b) {
    asm volatile("s_waitcnt vmcnt(0)" ::: "memory");
    __syncthreads();
    if (b.wave == 0 && pg8::lane_id_asm() == 0) {
        unsigned* bar = b.bar;
        __builtin_amdgcn_s_waitcnt(0);
        unsigned nloc = b.st[0], nx = b.st[1];
        if (nloc == 0u) { xcd_barrier_complete(bar, b.x, nloc, nx); b.st[0] = nloc; b.st[1] = nx; }
        const unsigned old = xb_add(&bar[XB_XSUB(b.x)], 1u);
        const unsigned gen = old / nloc;
        if (old + 1u == (gen + 1u) * nloc) {
            __builtin_amdgcn_fence(__ATOMIC_RELEASE, "agent");
            asm volatile("s_waitcnt vmcnt(0)" ::: "memory");
            const unsigned og = xb_add(&bar[XB_TOP], 1u);
            const unsigned tg = og / nx;
            if (og + 1u == (tg + 1u) * nx) xb_add(&bar[XB_TOPGEN], 1u);
            else XB_SPIN(xb_ld(&bar[XB_TOPGEN]) == tg, bar);
            __builtin_amdgcn_fence(__ATOMIC_ACQUIRE, "agent");
            xb_add(&bar[XB_XGEN(b.x)], 1u);
            asm volatile("s_waitcnt vmcnt(0)" ::: "memory");
        } else {
            XB_SPIN(xb_ld(&bar[XB_XGEN(b.x)]) == gen, bar);
            __builtin_amdgcn_fence(__ATOMIC_ACQUIRE, "agent");
            asm volatile("s_waitcnt vmcnt(0)" ::: "memory");
        }
    }
    __syncthreads();
}

__device__ __forceinline__ void sub_barrier(unsigned* cnt, unsigned n, int wave) {
    asm volatile("s_waitcnt vmcnt(0)" ::: "memory");
    __syncthreads();
    if (wave == 0 && pg8::lane_id_asm() == 0) {
        __builtin_amdgcn_fence(__ATOMIC_RELEASE, "agent");
        asm volatile("s_waitcnt vmcnt(0)" ::: "memory");
        __hip_atomic_fetch_add(cnt, 1u, __ATOMIC_RELAXED, __HIP_MEMORY_SCOPE_AGENT);
        unsigned spins = 0;
        while (__hip_atomic_load(cnt, __ATOMIC_RELAXED, __HIP_MEMORY_SCOPE_AGENT) < n) { __builtin_amdgcn_s_sleep(2); if (++spins > (1u << 22)) break; }
        __builtin_amdgcn_fence(__ATOMIC_ACQUIRE, "agent");
        asm volatile("s_waitcnt vmcnt(0)" ::: "memory");
    }
    __syncthreads();
}
#define LAYER_BODY(l) do { \
        { \
          { pg8::Gemm g{XB, WIN, D}; pg8::MixedOrder S; S.init(DIN, D / 64, 0, G, bx); pg8::EpiStore E{Z, ZLD, nullptr, (const float*)(a.ws + WS_RS)}; \
            pg8::gemm_phase<pg8::EpiStore, pg8::MixedOrder, true, true>(lds, g, S, E, wave); } \
          xcd_barrier(bar); \
          if (bx < 16) {   \
            { pg8::Gemm g{XB, WIN, D}; pg8::SampleOrder S; S.init(DIN, D / 64, bx); pg8::EpiStore E{Z, ZLD, nullptr, (const float*)(a.ws + WS_RS)}; \
              pg8::gemm_phase<pg8::EpiStore, pg8::SampleOrder, true, true>(lds, g, S, E, wave); } \
            sub_barrier((unsigned*)a.ws + 3520 + 64 * l, 16u, wave); \
          } \
          mixer_phase(a, l, bx < 16 ? 5120 + bx * 8 + wave : (bx - 16) * 8 + wave, bx < 16 ? 5280 : 5120, bx < 16 ? 128 : 1920, 0, lds + wave * 16384); \
        } \
        xcd_barrier(bar); \
        { pg8::Gemm g{MIXIN, WOUT, D}; pg8::MixedOrder S; S.init(D, D / 64, NS_OUT, G, bx); pg8::EpiStore E{MIX, D, (float*)(a.ws + WS_PART), nullptr}; \
          pg8::gemm_phase<pg8::EpiStore, pg8::MixedOrder, true, true>(lds, g, S, E, wave); } \
        xcd_barrier(bar); \
        xupd_phase(a, a.in[13] + l * D, NS_OUT, false, gw, NGW, 0); \
        xcd_barrier(bar); \
        { pg8::Gemm g{XB, WUP, D}; pg8::MixedOrder S; S.init(DUP, D / 64, 1, G, bx); \
          pg8::EpiUp E{ACT, (float*)(a.ws + WS_HEAD), (float*)(a.ws + WS_TAIL), a.in[17] + (size_t)l * 3 * DUP, (const float*)(a.ws + WS_RS)}; \
          pg8::gemm_phase<pg8::EpiUp, pg8::MixedOrder, true, true>(lds, g, S, E, wave); } \
        xcd_barrier(bar); \
        { pg8::Gemm g{ACT, WDN, DFF}; pg8::MixedOrder S; S.init(D, DFF / 64, NS_DN, G, bx); pg8::EpiStore E{MIX, D, (float*)(a.ws + WS_PART), nullptr}; \
          fixup_for_units(a, l, S, wave, bx, G * 512); \
          pg8::gemm_phase<pg8::EpiStore, pg8::MixedOrder, true, true>(lds, g, S, E, wave); } \
        xcd_barrier(bar); \
        xupd_phase(a, a.in[15] + l * D, NS_DN, l == DEPTH - 1, gw, NGW, 0); \
        if (l + 1 < DEPTH) { convert_weights(a, l + 1, scr, gw, NGW, 0); xcd_barrier(bar); } \
 } while (0)
__global__ void __launch_bounds__(512, 2) fwd_megakernel(Args a) {
    extern __shared__ __attribute__((aligned(16))) unsigned char lds_raw[];
    LAS unsigned char* lds = (LAS unsigned char*)lds_raw;
    cg::grid_group grid = cg::this_grid();
    const int wave = __builtin_amdgcn_readfirstlane((int)threadIdx.x >> 6);
    const int G = gridDim.x, bx = blockIdx.x;
    const int vcu = (G % 8 == 0) ? (bx % 8) * (G / 8) + bx / 8 : bx;
    const int gw = vcu * 8 + wave, NGW = G * 8;
    LAS float* scr = (LAS float*)(lds + wave * 16384);
    bf16* XB = (bf16*)(a.ws + WS_XB); bf16* Z = (bf16*)(a.ws + WS_Z); bf16* MIXIN = (bf16*)(a.ws + WS_MIXIN); bf16* MIX = (bf16*)(a.ws + WS_MIX); bf16* ACT = (bf16*)(a.ws + WS_ACT);
    const bf16* WIN = (const bf16*)(a.ws + WS_WIN); const bf16* WOUT = (const bf16*)(a.ws + WS_WOUT); const bf16* WUP = (const bf16*)(a.ws + WS_WUP); const bf16* WDN = (const bf16*)(a.ws + WS_WDN);

    volatile LAS unsigned* bst = (volatile LAS unsigned*)(lds + 131072);
    if (threadIdx.x < 2) bst[threadIdx.x] = 0u;
    __syncthreads();
    XcdBarrier bar = xcd_barrier_post((unsigned*)a.ws, bst); bar.wave = wave;
    if (a.ws == nullptr) grid.sync();
    convert_weights(a, 0, scr, gw, NGW, 0);
    x_prologue(a, gw, NGW, 0);
    xcd_barrier(bar);
    LAYER_BODY(0); LAYER_BODY(1); LAYER_BODY(2); LAYER_BODY(3);
}

extern "C" void kernel_launch(void* const* d_in, const int* in_sizes, int n_in, void* d_out, int out_size, void* d_ws, size_t ws_size, hipStream_t stream) {
    static int grid = 0;
    if (grid == 0) {
        if (n_in != 20 || (size_t)out_size != OUT_END || ws_size < WS_END) { fprintf(stderr, "kernel_launch: unexpected shapes (n_in %d out %d ws %zu); nothing launched\n", n_in, out_size, ws_size); grid = -1; return; }
        int dev = 0, cus = 0, per_cu = 0;
        (void)hipGetDevice(&dev);
        (void)hipDeviceGetAttribute(&cus, hipDeviceAttributeMultiprocessorCount, dev);
        (void)hipFuncSetAttribute((const void*)fwd_megakernel, hipFuncAttributeMaxDynamicSharedMemorySize, LDS_BYTES);
        (void)hipOccupancyMaxActiveBlocksPerMultiprocessor(&per_cu, (const void*)fwd_megakernel, 512, LDS_BYTES);
        if (per_cu < 1) per_cu = 1;
        grid = cus * per_cu;
        if (grid != 256) { fprintf(stderr, "kernel_launch: this kernel's phase program is laid out for 256 resident workgroups (one per CU of a 256-CU device), got %d; nothing launched\n", grid); grid = -1; return; }
    }
    if (grid < 0) return;
    if (hipMemsetAsync(d_ws, 0, 16384, stream) != hipSuccess) { fprintf(stderr, "kernel_launch: hipMemsetAsync of the barrier words failed\n"); return; }
    Args a{};
    for (int i = 0; i < 20; ++i) a.in[i] = (const float*)d_in[i];
    a.out = (float*)d_out; a.ws = (unsigned char*)d_ws;
    void* args[] = {&a};
    hipError_t e = hipLaunchCooperativeKernel((const void*)fwd_megakernel, dim3(grid), dim3(512), args, LDS_BYTES, stream);
    if (e != hipSuccess) fprintf(stderr, "cooperative launch failed: %s (grid %d)\n", hipGetErrorString(e), grid);
}
```
